# Optimizing an MI355X kernel written in HIP

```python
import jax, jax.numpy as jnp
from jax import lax
import numpy as np

D_MODEL = 1024
BATCH = 32
SEQ = 2048
DEPTH = 1

CHUNK = 64
EPS = 1e-6
RWKV_HEAD = 64
RWKV_HEADS = 8
RWKV_WIDTH = RWKV_HEADS * RWKV_HEAD
DECAY_LORA = 64
ICLR_LORA = 64
GATE_LORA = 128
GN_EPS = 64e-5
MLSTM_HEADS = 4
MLSTM_DK = 64
MLSTM_DV = 128
MLSTM_QK = MLSTM_HEADS * MLSTM_DK
MLSTM_WIDTH = MLSTM_HEADS * MLSTM_DV
CONV_WIDTH = 4
GATE_SOFTCAP = 15.0
MIX_WIDTH = RWKV_WIDTH + MLSTM_WIDTH
RWKV_COLS = 3 * RWKV_WIDTH + DECAY_LORA + ICLR_LORA + GATE_LORA
MLSTM_COLS = 2 * MLSTM_QK + 2 * MLSTM_WIDTH + 2 * MLSTM_HEADS
IN_COLS = RWKV_COLS + MLSTM_COLS
N_GROUPS = 4
EXPERTS_PER_GROUP = 8
N_EXPERTS = N_GROUPS * EXPERTS_PER_GROUP
TOP_K = 2
D_EXPERT = 256

kernel_name = 'hybrid_rwkv7_mlstm_hmoe_block'


def rms_norm(x, w):
    xf = x.astype(jnp.float32)
    y = xf * lax.rsqrt(jnp.mean(xf * xf, axis=-1, keepdims=True) + EPS)
    return (y * w.astype(jnp.float32)).astype(x.dtype)


def modulate(xn, shift, scale):
    return xn * (1.0 + scale[:, None, :]) + shift[:, None, :]


def token_shift(u, mu):
    prev = jnp.pad(u, ((0, 0), (1, 0), (0, 0)))[:, :-1]
    return u + (prev - u) * mu


def causal_dwconv(u, w, b):
    ch = u.shape[-1]
    out = lax.conv_general_dilated(
        u, w[:, None, :].astype(u.dtype), window_strides=(1,),
        padding=[(w.shape[0] - 1, 0)], dimension_numbers=('NWC', 'WIO', 'NWC'),
        feature_group_count=ch)
    return out + b


def softcap(z):
    return GATE_SOFTCAP * jnp.tanh(z / GATE_SOFTCAP)


def rwkv7_group(u, mu, w0, w_up, a0, a_up, g_up, k_k, k_a, r_k, gn_w, gn_b):
    bsz, seq, _ = u.shape
    f32 = jnp.float32
    u = token_shift(u, mu)
    o1 = RWKV_WIDTH
    o2 = 2 * RWKV_WIDTH
    o3 = 3 * RWKV_WIDTH
    o4 = o3 + DECAY_LORA
    o5 = o4 + ICLR_LORA
    r, k, v, wd, ad, gd = jnp.split(u, [o1, o2, o3, o4, o5], axis=-1)
    w_log = -jax.nn.softplus(-(w0 + jnp.tanh(wd) @ w_up)) - 0.5
    decay = jnp.exp(-jnp.exp(w_log.astype(f32)))
    a = jax.nn.sigmoid(a0 + ad @ a_up)
    g = jax.nn.sigmoid(gd) @ g_up
    heads = lambda t: t.reshape(bsz, seq, RWKV_HEADS, RWKV_HEAD).astype(f32)
    kk = heads(k * k_k)
    kk = kk / jnp.maximum(jnp.sqrt(jnp.sum(kk * kk, axis=-1, keepdims=True)), 1e-12)
    k = k * (1.0 + (a - 1.0) * k_a)
    r_h, k_h, v_h, w_h, a_h = heads(r), heads(k), heads(v), heads(decay), heads(a)
    b_h = kk * a_h

    def step(state, inp):
        r_t, w_t, k_t, v_t, kk_t, b_t = inp
        sa = jnp.einsum('bhij,bhj->bhi', state, -kk_t)
        state = (state * w_t[:, :, None, :] + sa[..., None] * b_t[:, :, None, :]
                 + v_t[..., None] * k_t[:, :, None, :])
        return state, jnp.einsum('bhij,bhj->bhi', state, r_t)

    xs = tuple(jnp.swapaxes(t, 0, 1) for t in (r_h, w_h, k_h, v_h, kk, b_h))
    state0 = jnp.zeros((bsz, RWKV_HEADS, RWKV_HEAD, RWKV_HEAD), f32)
    _, y = lax.scan(step, state0, xs)
    y = jnp.swapaxes(y, 0, 1)
    mean = jnp.mean(y, axis=-1, keepdims=True)
    var = jnp.mean(jnp.square(y - mean), axis=-1, keepdims=True)
    y = (y - mean) * lax.rsqrt(var + GN_EPS)
    y = y.reshape(bsz, seq, RWKV_WIDTH) * gn_w + gn_b
    bonus = jnp.sum(r_h * k_h * r_k.astype(f32), axis=-1, keepdims=True) * v_h
    y = (y + bonus.reshape(bsz, seq, RWKV_WIDTH)) * g
    return y.astype(u.dtype)


def to_chunks(t):
    bsz, seq, nh = t.shape[:3]
    t = t.reshape((bsz, seq // CHUNK, CHUNK, nh) + t.shape[3:])
    return t.transpose((1, 0, 3, 2) + tuple(range(4, t.ndim)))


def mlstm_chunkwise(q, k, v, log_i, log_f):
    bsz, seq = q.shape[:2]
    f32 = jnp.float32
    causal = jnp.tril(jnp.ones((CHUNK, CHUNK), dtype=bool))

    def step(carry, inp):
        c_mat, n_vec, m = carry
        qc, kc, vc, li, lf = inp
        b = jnp.cumsum(lf, axis=-1)
        d_mat = jnp.where(causal, b[..., :, None] - b[..., None, :] + li[..., None, :], -jnp.inf)
        inter = b + m[..., None]
        m_t = jnp.maximum(inter, jnp.max(d_mat, axis=-1))
        scores = jnp.einsum('bhtd,bhsd->bhts', qc, kc) * jnp.exp(d_mat - m_t[..., None])
        w_inter = jnp.exp(inter - m_t)
        num = (jnp.einsum('bhts,bhsv->bhtv', scores, vc)
               + w_inter[..., None] * jnp.einsum('bhtd,bhdv->bhtv', qc, c_mat))
        den = jnp.sum(scores, axis=-1) + w_inter * jnp.einsum('bhtd,bhd->bht', qc, n_vec)
        h = num / jnp.maximum(jnp.abs(den), jnp.exp(-m_t))[..., None]
        end_log = b[..., -1:] - b + li
        m_new = jnp.maximum(b[..., -1] + m, jnp.max(end_log, axis=-1))
        carry_w = jnp.exp(b[..., -1] + m - m_new)
        kw = kc * jnp.exp(end_log - m_new[..., None])[..., None]
        c_mat = carry_w[..., None, None] * c_mat + jnp.einsum('bhsd,bhsv->bhdv', kw, vc)
        n_vec = carry_w[..., None] * n_vec + jnp.sum(kw, axis=-2)
        return (c_mat, n_vec, m_new), h

    carry0 = (jnp.zeros((bsz, MLSTM_HEADS, MLSTM_DK, MLSTM_DV), f32),
              jnp.zeros((bsz, MLSTM_HEADS, MLSTM_DK), f32),
              jnp.zeros((bsz, MLSTM_HEADS), f32))
    xs = (to_chunks(q * (MLSTM_DK ** -0.5)), to_chunks(k), to_chunks(v),
          to_chunks(log_i), to_chunks(log_f))
    _, h = lax.scan(step, carry0, xs)
    return h.transpose(1, 0, 3, 2, 4).reshape(bsz, seq, MLSTM_HEADS, MLSTM_DV)


def mlstm_group(u, conv_w, conv_b, i_b, f_b, hn_w):
    bsz, seq, _ = u.shape
    f32 = jnp.float32
    o1 = 2 * MLSTM_QK
    o2 = o1 + MLSTM_WIDTH
    o3 = o2 + MLSTM_WIDTH
    o4 = o3 + MLSTM_HEADS
    qk, v, o, ig, fg = jnp.split(u, [o1, o2, o3, o4], axis=-1)
    qk = jax.nn.silu(causal_dwconv(qk, conv_w, conv_b))
    q, k = jnp.split(qk, 2, axis=-1)
    log_i = softcap((ig + i_b).astype(f32))
    log_f = jax.nn.log_sigmoid(softcap((fg + f_b).astype(f32)))
    heads_k = lambda t: t.reshape(bsz, seq, MLSTM_HEADS, MLSTM_DK).astype(f32)
    h = mlstm_chunkwise(heads_k(q), heads_k(k),
                        v.reshape(bsz, seq, MLSTM_HEADS, MLSTM_DV).astype(f32), log_i, log_f)
    h = h * lax.rsqrt(jnp.mean(h * h, axis=-1, keepdims=True) + EPS)
    h = h.reshape(bsz, seq, MLSTM_WIDTH) * hn_w
    return (h * jax.nn.sigmoid(o.astype(f32))).astype(u.dtype)


def hier_moe(xn, w_group, b_group, w_router, b_router, w_gate, w_up, w_down):
    bsz, seq, _ = xn.shape
    f32 = jnp.float32
    g_logits = (xn @ w_group + b_group).astype(f32)
    g_prob = jax.nn.softmax(g_logits, axis=-1)
    g_idx = jnp.argmax(g_logits, axis=-1)
    g_onehot = jax.nn.one_hot(g_idx, N_GROUPS, dtype=f32)
    g_w = jnp.max(g_prob, axis=-1)
    e_logits = (xn @ w_router + b_router).astype(f32).reshape(bsz, seq, N_GROUPS, EXPERTS_PER_GROUP)
    sel = jnp.sum(e_logits * g_onehot[..., None], axis=2)
    top_v, top_i = lax.top_k(sel, TOP_K)
    top_w = jax.nn.softmax(top_v, axis=-1)
    within = jnp.sum(jax.nn.one_hot(top_i, EXPERTS_PER_GROUP, dtype=f32) * top_w[..., None], axis=-2)
    combine = (g_onehot[..., None] * within[..., None, :] * g_w[..., None, None])
    combine = combine.reshape(bsz, seq, N_EXPERTS).astype(xn.dtype)

    def per_sequence(args):
        xs, cw = args
        hg = jnp.einsum('sd,edf->sef', xs, w_gate)
        hu = jnp.einsum('sd,edf->sef', xs, w_up)
        act = jax.nn.silu(hg) * hu * cw[..., None]
        return jnp.einsum('sef,efd->sd', act, w_down)

    return lax.map(per_sequence, (xn, combine))


def setup_inputs(seed: int = 0) -> dict:
    key = jax.random.key(seed)
    ks = jax.random.split(key, 32)
    L, D = DEPTH, D_MODEL

    def nrm(i, shape, scale):
        return scale * jax.random.normal(ks[i], shape, jnp.float32)

    def uni(i, shape, lo, hi):
        return jax.random.uniform(ks[i], shape, jnp.float32, lo, hi)

    return {
        'x': nrm(0, (BATCH, SEQ, D), 1.0),
        'c': nrm(1, (BATCH, D), 1.0),
        'ada_w': nrm(2, (L, D, 6 * D), 0.5 * D ** -0.5),
        'ada_b': nrm(3, (L, 6 * D), 0.01),
        'mix_norm_w': 1.0 + nrm(4, (L, D), 0.02),
        'w_in': nrm(5, (L, D, IN_COLS), D ** -0.5),
        'rwkv_mu': uni(6, (L, RWKV_COLS), 0.0, 1.0),
        'rwkv_w0': uni(7, (L, RWKV_WIDTH), -4.0, 0.0),
        'rwkv_w_up': nrm(8, (L, DECAY_LORA, RWKV_WIDTH), DECAY_LORA ** -0.5),
        'rwkv_a0': nrm(9, (L, RWKV_WIDTH), 0.5),
        'rwkv_a_up': nrm(10, (L, ICLR_LORA, RWKV_WIDTH), ICLR_LORA ** -0.5),
        'rwkv_g_up': nrm(11, (L, GATE_LORA, RWKV_WIDTH), GATE_LORA ** -0.5),
        'rwkv_k_k': 0.85 + nrm(12, (L, RWKV_WIDTH), 0.05),
        'rwkv_k_a': 1.0 + nrm(13, (L, RWKV_WIDTH), 0.05),
        'rwkv_r_k': nrm(14, (L, RWKV_HEADS, RWKV_HEAD), 0.1),
        'rwkv_gn_w': 1.0 + nrm(15, (L, RWKV_WIDTH), 0.02),
        'rwkv_gn_b': nrm(16, (L, RWKV_WIDTH), 0.01),
        'mlstm_conv_w': nrm(17, (L, CONV_WIDTH, 2 * MLSTM_QK), CONV_WIDTH ** -0.5),
        'mlstm_conv_b': nrm(18, (L, 2 * MLSTM_QK), 0.01),
        'mlstm_i_b': -3.0 + nrm(19, (L, MLSTM_HEADS), 0.1),
        'mlstm_f_b': jnp.linspace(3.0, 6.0, MLSTM_HEADS, dtype=jnp.float32)[None, :] + nrm(20, (L, MLSTM_HEADS), 0.1),
        'mlstm_hn_w': 1.0 + nrm(21, (L, MLSTM_WIDTH), 0.02),
        'w_out': nrm(22, (L, MIX_WIDTH, D), MIX_WIDTH ** -0.5),
        'ffn_norm_w': 1.0 + nrm(23, (L, D), 0.02),
        'moe_w_group': nrm(24, (L, D, N_GROUPS), D ** -0.5),
        'moe_b_group': nrm(25, (L, N_GROUPS), 0.01),
        'moe_w_router': nrm(26, (L, D, N_EXPERTS), D ** -0.5),
        'moe_b_router': nrm(27, (L, N_EXPERTS), 0.01),
        'moe_w_gate': nrm(28, (L, N_EXPERTS, D, D_EXPERT), D ** -0.5),
        'moe_w_up': nrm(29, (L, N_EXPERTS, D, D_EXPERT), D ** -0.5),
        'moe_w_down': nrm(30, (L, N_EXPERTS, D_EXPERT, D), D_EXPERT ** -0.5),
        'final_norm_w': 1.0 + nrm(31, (D,), 0.02),
    }


def reference(x, c, ada_w, ada_b, mix_norm_w, w_in, rwkv_mu, rwkv_w0, rwkv_w_up, rwkv_a0,
              rwkv_a_up, rwkv_g_up, rwkv_k_k, rwkv_k_a, rwkv_r_k, rwkv_gn_w, rwkv_gn_b,
              mlstm_conv_w, mlstm_conv_b, mlstm_i_b, mlstm_f_b, mlstm_hn_w, w_out, ffn_norm_w,
              moe_w_group, moe_b_group, moe_w_router, moe_b_router, moe_w_gate, moe_w_up,
              moe_w_down, final_norm_w):
    for l in range(DEPTH):
        mod = jax.nn.silu(c) @ ada_w[l] + ada_b[l]
        sh_m, sc_m, g_m, sh_f, sc_f, g_f = jnp.split(mod, 6, axis=-1)
        h = modulate(rms_norm(x, mix_norm_w[l]), sh_m, sc_m)
        proj = h @ w_in[l]
        y_r = rwkv7_group(proj[..., :RWKV_COLS], rwkv_mu[l], rwkv_w0[l], rwkv_w_up[l], rwkv_a0[l],
                          rwkv_a_up[l], rwkv_g_up[l], rwkv_k_k[l], rwkv_k_a[l], rwkv_r_k[l],
                          rwkv_gn_w[l], rwkv_gn_b[l])
        y_m = mlstm_group(proj[..., RWKV_COLS:], mlstm_conv_w[l], mlstm_conv_b[l], mlstm_i_b[l],
                          mlstm_f_b[l], mlstm_hn_w[l])
        y = jnp.concatenate([y_r, y_m], axis=-1) @ w_out[l]
        x = x + g_m[:, None, :] * y
        h = modulate(rms_norm(x, ffn_norm_w[l]), sh_f, sc_f)
        y = hier_moe(h, moe_w_group[l], moe_b_group[l], moe_w_router[l], moe_b_router[l],
                     moe_w_gate[l], moe_w_up[l], moe_w_down[l])
        x = x + g_f[:, None, :] * y
    return rms_norm(x, final_norm_w)
```

```cpp
#include <hip/hip_runtime.h>
#include <cstdio>
#include <cstdint>

#ifndef MK_ONE_LAUNCH
#define MK_ONE_LAUNCH 1
#endif

#define RKP (MK_DUP - 30)
#ifndef MK_DUP
#define MK_DUP -1
#endif
#define LAS __attribute__((address_space(3)))
#define GAS __attribute__((address_space(1)))
typedef unsigned short bf16_t;
typedef short bf16x8 __attribute__((ext_vector_type(8)));
typedef float f32x4 __attribute__((ext_vector_type(4)));
typedef float f32x2 __attribute__((ext_vector_type(2)));
typedef unsigned u32x4 __attribute__((ext_vector_type(4)));
typedef unsigned u32x2 __attribute__((ext_vector_type(2)));
typedef short s16x4 __attribute__((ext_vector_type(4)));

constexpr int D = 1024, NB = 32, SEQ = 2048, T = NB * SEQ;
constexpr int IN_COLS = 3336, NPROJ = 3328;
constexpr int C_R = 0, C_K = 512, C_V = 1024, C_WD = 1536, C_AD = 1600, C_GD = 1664, C_MQ = 1792, C_MK = 2048, C_MV = 2304, C_MO = 2816;
constexpr int NE = 32, DE = 256;
constexpr int MAXTILES = 544;
constexpr int NTHR = 512, NWAVES = 8;

constexpr size_t MiB = 1u << 20;
constexpr size_t WS_CTL = 0, CTL_ZERO_BYTES = 64 * 1024;
constexpr size_t WS_MOD = 1 * MiB;
constexpr size_t WS_LORA = 2 * MiB;
constexpr size_t WS_ROUTE = 3 * MiB;
constexpr size_t WS_ROUTEW = 4 * MiB + 512 * 1024;
constexpr size_t WS_SLOT = 5 * MiB;
constexpr size_t WS_GATES = 7 * MiB;
constexpr size_t WS_WIN = 10 * MiB;
constexpr size_t WS_WOUT = 17 * MiB;
constexpr size_t WS_W1 = 20 * MiB;
constexpr size_t WS_W2 = 52 * MiB;
constexpr size_t WS_H = 72 * MiB;
constexpr size_t WS_MIX = 200 * MiB;
constexpr size_t WS_PROJ = 328 * MiB;
constexpr size_t WS_HACT = 328 * MiB;
constexpr size_t WS_MOE = 400 * MiB;
constexpr size_t WS_X1 = 744 * MiB;
constexpr size_t WS_END = 872 * MiB;
constexpr int CW_BAR = 1024;
constexpr int CW_CNT = 8192;

constexpr int LDS_BYTES = 159744;
constexpr int MISC_OFF = 151552;

typedef __bf16 bf16v2 __attribute__((ext_vector_type(2)));
__device__ __forceinline__ unsigned cvt_pk_bf16(float lo, float hi) { const f32x2 f = {lo, hi}; const bf16v2 v = __builtin_convertvector(f, bf16v2); return __builtin_bit_cast(unsigned, v); }
__device__ __forceinline__ bf16_t f2bf(float f) { return (bf16_t)(cvt_pk_bf16(f, 0.f) & 0xffffu); }
__device__ __forceinline__ float bf_lo(unsigned u) { return __uint_as_float(u << 16); }
__device__ __forceinline__ float bf_hi(unsigned u) { return __uint_as_float(u & 0xffff0000u); }
__device__ __forceinline__ float bf2f(bf16_t b) { return __uint_as_float(((unsigned)b) << 16); }
__device__ __forceinline__ float fsigmoid(float x) { return __builtin_amdgcn_rcpf(1.0f + __expf(-x)); }
__device__ __forceinline__ float ftanh(float x) { x = fminf(fmaxf(x, -15.f), 15.f); const float e = __expf(2.0f * x); return 1.0f - 2.0f * __builtin_amdgcn_rcpf(e + 1.0f); }
__device__ __forceinline__ float fsilu(float x) { return x * fsigmoid(x); }
template <int CTRL> __device__ __forceinline__ float dppf(float x) { return __builtin_bit_cast(float, __builtin_amdgcn_mov_dpp(__builtin_bit_cast(int, x), CTRL, 0xf, 0xf, true)); }
__device__ __forceinline__ float row16_sum(float v) { v += dppf<0xB1>(v); v += dppf<0x4E>(v); v += dppf<0x141>(v); v += dppf<0x140>(v); return v; }
__device__ __forceinline__ float row8_sum(float v) { v += dppf<0xB1>(v); v += dppf<0x4E>(v); v += dppf<0x141>(v); return v; }
__device__ __forceinline__ float wave_sum_l63(float v) {
    v = row16_sum(v);
    v += __builtin_bit_cast(float, __builtin_amdgcn_update_dpp(0, __builtin_bit_cast(int, v), 0x142, 0xa, 0xf, false));
    v += __builtin_bit_cast(float, __builtin_amdgcn_update_dpp(0, __builtin_bit_cast(int, v), 0x143, 0xc, 0xf, false));
    return v; }
__device__ __forceinline__ float wave_sum(float v) { return __builtin_bit_cast(float, __builtin_amdgcn_readlane(__builtin_bit_cast(int, wave_sum_l63(v)), 63)); }
#define LDS_WAIT() asm volatile("s_waitcnt lgkmcnt(0)" ::: "memory")
#define VM_WAIT() asm volatile("s_waitcnt vmcnt(0)" ::: "memory")

#define XB_TMO      128
#define XB_XCNT(j)  (256  + 64 * (j))
#define XB_XSUB(j)  (1280 + 64 * (j))
#define XB_XGEN(j)  (2304 + 64 * (j))
#define XB_TOP      3328
#define XB_TOPGEN   3392
#define XCD_BAR_WORDS 3456
#define XB_SPIN_CAP (1u << 18)

__device__ __forceinline__ unsigned xb_ld(unsigned* p)              { return __hip_atomic_load(p, __ATOMIC_RELAXED, __HIP_MEMORY_SCOPE_AGENT); }
__device__ __forceinline__ unsigned xb_add(unsigned* p, unsigned v) { return __hip_atomic_fetch_add(p, v, __ATOMIC_RELAXED, __HIP_MEMORY_SCOPE_AGENT); }
__device__ __forceinline__ unsigned xb_xcc_id() { return (unsigned)__builtin_amdgcn_s_getreg((3 << 11) | 20) & 0xFu; }
#define XB_SPIN(cond, bar) do { unsigned _sp = 0; while (cond) { __builtin_amdgcn_s_sleep(1); \
    if ((++_sp & 255u) == 0u) { if (xb_ld(&(bar)[XB_TMO])) break; if (_sp > XB_SPIN_CAP) { atomicAdd(&(bar)[XB_TMO], 1u); break; } } } } while (0)

struct XcdBarrier {
    unsigned* bar; unsigned x;
    volatile LAS unsigned* st;
};

__device__ __forceinline__ XcdBarrier xcd_barrier_post(unsigned* bar, volatile LAS unsigned* st) {
    XcdBarrier b; b.bar = bar; b.x = xb_xcc_id(); b.st = st;
    if (threadIdx.x == 0) (void)xb_add(&bar[XB_XCNT(b.x)], 1u);
    return b;
}
__device__ __forceinline__ void xcd_barrier_complete(unsigned* bar, unsigned x, unsigned& nloc, unsigned& nx) {
    const unsigned G = gridDim.x * gridDim.y * gridDim.z;
    unsigned sum, cnt, mine, sp = 0u;
    for (;;) {
        sum = 0u; cnt = 0u; mine = 0u;
#pragma unroll
        for (unsigned j = 0; j < 16; ++j) { const unsigned c = xb_ld(&bar[XB_XCNT(j)]); sum += c; cnt += (c > 0u) ? 1u : 0u; mine = (j == x) ? c : mine; }
        if (sum == G) break;
        __builtin_amdgcn_s_sleep(1);
        if ((++sp & 255u) == 0u) { if (xb_ld(&bar[XB_TMO])) break; if (sp > XB_SPIN_CAP) { atomicAdd(&bar[XB_TMO], 1u); break; } }
    }
    nloc = mine > 0u ? mine : 1u; nx = cnt > 0u ? cnt : 1u;
}

__device__ __forceinline__ void xcd_barrier(const XcdBarrier& b) {
    asm volatile("s_waitcnt vmcnt(0)" ::: "memory");
    __syncthreads();
    if (threadIdx.x == 0) {
        unsigned* bar = b.bar;
        __builtin_amdgcn_s_waitcnt(0);
        unsigned nloc = b.st[0], nx = b.st[1];
        if (nloc == 0u) { xcd_barrier_complete(bar, b.x, nloc, nx); b.st[0] = nloc; b.st[1] = nx; }
        const unsigned old = xb_add(&bar[XB_XSUB(b.x)], 1u);
        const unsigned gen = old / nloc;
        if (old + 1u == (gen + 1u) * nloc) {
            __builtin_amdgcn_fence(__ATOMIC_RELEASE, "agent");
            asm volatile("s_waitcnt vmcnt(0)" ::: "memory");
            const unsigned og = xb_add(&bar[XB_TOP], 1u);
            const unsigned tg = og / nx;
            if (og + 1u == (tg + 1u) * nx) xb_add(&bar[XB_TOPGEN], 1u);
            else XB_SPIN(xb_ld(&bar[XB_TOPGEN]) == tg, bar);
            __builtin_amdgcn_fence(__ATOMIC_ACQUIRE, "agent");
            xb_add(&bar[XB_XGEN(b.x)], 1u);
            asm volatile("s_waitcnt vmcnt(0)" ::: "memory");
        } else {
            XB_SPIN(xb_ld(&bar[XB_XGEN(b.x)]) == gen, bar);
            __builtin_amdgcn_fence(__ATOMIC_ACQUIRE, "agent");
            asm volatile("s_waitcnt vmcnt(0)" ::: "memory");
        }
    }
    __syncthreads();
}

namespace pg8 {
#ifndef MK_SP2
#define MK_SP2 1
#endif
constexpr bool PG8_SP2 = MK_SP2 != 0;
constexpr int BM = 256, BK = 64, HALF = 128, HTB = HALF * BK * 2  , STAGE_BYTES = 8 * HTB, NXCD = 8;
__device__ __forceinline__ int lds_byte(int r, int c) { const int st = (r >> 4) * 2 + (c >> 5), rr = r & 15, cc = c & 31, ob = rr * 64 + cc * 2; return st * 1024 + (ob ^ (((ob >> 9) & 1) << 5)); }
__device__ __forceinline__ void stage_rc(int b, int& R, int& C) { const int st = b / 1024, sb = b % 1024, swz = sb ^ (((sb >> 9) & 1) << 5); R = (st >> 1) * 16 + swz / 64; C = (st & 1) * 32 + (swz % 64) / 2; }
__device__ __forceinline__ int perm32(int rho) { const int n = rho >> 4, i = rho & 15; return 8 * (i >> 2) + 4 * n + (i & 3); }

struct Unit { int pm, pn, e; };

__device__ __forceinline__ int xcd_remap(int L, int nwg) { const int q = nwg / NXCD, r = nwg % NXCD, xcd = L % NXCD, off = L / NXCD; return (xcd < r ? xcd * (q + 1) : r * (q + 1) + (xcd - r) * q) + off; }

template <int K, class Epi, class Sched>
__device__ __forceinline__ void gemm_phase(LAS unsigned char* lds, const Sched& S, const Epi& E) {
    const int tid = threadIdx.x, wid = __builtin_amdgcn_readfirstlane(tid >> 6), lane = tid & 63, wr = wid >> 2, wc = wid & 3, fr = lane & 15, fq = lane >> 4;
    constexpr int nt = K / BK;
    static_assert(K % 128 == 0 && K >= 256, "K");
    int Rr[2], Cc[2]; unsigned voffB[2];
#pragma unroll
    for (int i = 0; i < 2; ++i) { stage_rc(tid * 16 + i * 8192, Rr[i], Cc[i]); const int Rb = Epi::PERM ? ((Rr[i] & ~31) + perm32(Rr[i] & 31)) : Rr[i]; voffB[i] = (unsigned)(Rb * K + Cc[i]) * 2u; }
    constexpr unsigned hstepB = (unsigned)HALF * K * 2;
    const unsigned ldsw = (unsigned)wid * 1024u;
    const int aoff = lds_byte(wr * 64 + fr, fq * 8), boff = lds_byte(wc * 32 + fr, fq * 8);
#define PG8_SA(b, h) (((b) * 2 + (h)) * HTB)
#define PG8_SB(b, h) ((4 + (b) * 2 + (h)) * HTB)
#define PG8_STAGE_A(bufoff, base, offs, h, kb) do { _Pragma("unroll") for (int _i = 0; _i < 2; ++_i) \
        __builtin_amdgcn_global_load_lds((const unsigned*)((base) + (size_t)((offs)[h][_i] + (unsigned)(kb))), (LAS unsigned*)(lds + (bufoff) + ldsw + _i * 8192), 16, 0, 0); } while (0)
#define PG8_STAGE_B(bufoff, base, h, kb) do { _Pragma("unroll") for (int _i = 0; _i < 2; ++_i) \
        __builtin_amdgcn_global_load_lds((const unsigned*)((base) + (size_t)(voffB[_i] + (unsigned)(h) * hstepB + (unsigned)(kb))), (LAS unsigned*)(lds + (bufoff) + ldsw + _i * 8192), 16, 0, 0); } while (0)
#define PG8_LDA(dst, b, h) do { _Pragma("unroll") for (int m = 0; m < 4; ++m) _Pragma("unroll") for (int k = 0; k < 2; ++k) dst[m][k] = *(const LAS bf16x8*)(lds + PG8_SA(b, h) + aoff + m * 2048 + k * 1024); } while (0)
#define PG8_LDB(dst, b, h) do { _Pragma("unroll") for (int n = 0; n < 2; ++n) _Pragma("unroll") for (int k = 0; k < 2; ++k) dst[n][k] = *(const LAS bf16x8*)(lds + PG8_SB(b, h) + boff + n * 2048 + k * 1024); } while (0)
#define PG8_MMA(ai, bj, At, Bt) do { __builtin_amdgcn_s_setprio(1); _Pragma("unroll") for (int m = 0; m < 4; ++m) _Pragma("unroll") for (int n = 0; n < 2; ++n) _Pragma("unroll") for (int k = 0; k < 2; ++k) \
        acc[ai][bj][m][n] = __builtin_amdgcn_mfma_f32_16x16x32_bf16(Bt[n][k], At[m][k], acc[ai][bj][m][n], 0, 0, 0); __builtin_amdgcn_s_setprio(0); } while (0)
#define PG8_WAIT_V(n) asm volatile("s_waitcnt vmcnt(" #n ")" ::: "memory")
#define PG8_WAIT_L(n) asm volatile("s_waitcnt lgkmcnt(" #n ")" ::: "memory")
#define PG8_BAR __builtin_amdgcn_s_barrier()
#define PG8_SCHED __builtin_amdgcn_sched_barrier(0)
    Unit cur, nxt; int ui = 0;
    if (!S.next(0, cur)) return;
    f32x4 acc[2][2][4][2];
#pragma unroll
    for (int a = 0; a < 2; ++a)
#pragma unroll
        for (int b = 0; b < 2; ++b)
#pragma unroll
            for (int m = 0; m < 4; ++m)
#pragma unroll
                for (int n = 0; n < 2; ++n) acc[a][b][m][n] = (f32x4){0.f, 0.f, 0.f, 0.f};
    bf16x8 At[4][2], B0[2][2], B1[2][2];
    unsigned cAo[2][2], nAo[2][2];
#pragma unroll
    for (int h = 0; h < 2; ++h)
#pragma unroll
        for (int i = 0; i < 2; ++i) {
            if constexpr (Sched::GATHER) cAo[h][i] = S.a_rowoff(cur, h * HALF + Rr[i]) + (unsigned)Cc[i] * 2u;
            else cAo[h][i] = (unsigned)((h * HALF + Rr[i]) * K + Cc[i]) * 2u;
            nAo[h][i] = cAo[h][i];
        }
    const char* cA = S.a_base(cur); const char* cB = S.b_base(cur);
    if constexpr (PG8_SP2) {
        PG8_STAGE_B(PG8_SB(0, 0), cB, 0, 0); PG8_STAGE_B(PG8_SB(0, 1), cB, 1, 0); PG8_STAGE_A(PG8_SA(0, 0), cA, cAo, 0, 0); PG8_STAGE_A(PG8_SA(0, 1), cA, cAo, 1, 0);
        if (wr == 1) PG8_BAR;
        PG8_WAIT_V(2); PG8_BAR;
        PG8_STAGE_B(PG8_SB(1, 0), cB, 0, 128); PG8_STAGE_A(PG8_SA(1, 0), cA, cAo, 0, 128); PG8_STAGE_B(PG8_SB(1, 1), cB, 1, 128);
        PG8_WAIT_V(6); PG8_BAR;
    } else {
    PG8_STAGE_B(PG8_SB(0, 0), cB, 0, 0); PG8_STAGE_A(PG8_SA(0, 0), cA, cAo, 0, 0); PG8_STAGE_B(PG8_SB(0, 1), cB, 1, 0); PG8_STAGE_A(PG8_SA(0, 1), cA, cAo, 1, 0);
    if (wr == 1) PG8_BAR;
    PG8_WAIT_V(4); PG8_BAR;
    PG8_STAGE_B(PG8_SB(1, 0), cB, 0, 128); PG8_STAGE_A(PG8_SA(1, 0), cA, cAo, 0, 128); PG8_STAGE_B(PG8_SB(1, 1), cB, 1, 128);
    PG8_WAIT_V(6); PG8_BAR;
    }
    for (;;) {
        const bool has_next = S.next(ui + 1, nxt);
        const char* nA = has_next ? S.a_base(nxt) : cA; const char* nB = has_next ? S.b_base(nxt) : cB;
        if constexpr (Sched::GATHER) {
#pragma unroll
            for (int h = 0; h < 2; ++h)
#pragma unroll
                for (int i = 0; i < 2; ++i) nAo[h][i] = has_next ? (S.a_rowoff(nxt, h * HALF + Rr[i]) + (unsigned)Cc[i] * 2u) : cAo[h][i];
        }
#pragma unroll 1
        for (int t = 0; t < nt; t += 2) {
            const bool last = (t == nt - 2);
            const unsigned k1 = (unsigned)(t + 1) * 128u;
            const char* a2 = last ? nA : cA; const char* b2 = last ? nB : cB;
            const unsigned k2 = last ? 0u : (unsigned)(t + 2) * 128u, k3 = k2 + 128u;
            unsigned a2o[2][2];
#pragma unroll
            for (int h = 0; h < 2; ++h)
#pragma unroll
                for (int i = 0; i < 2; ++i) { if constexpr (Sched::GATHER) a2o[h][i] = last ? nAo[h][i] : cAo[h][i]; else a2o[h][i] = cAo[h][i]; }
            if constexpr (PG8_SP2) {
            const bool rlx = (t == 0) && (ui > 0);
            PG8_LDB(B0, 0, 0); PG8_LDB(B1, 0, 1); PG8_SCHED; PG8_LDA(At, 0, 0); PG8_STAGE_A(PG8_SA(1, 1), cA, cAo, 1, k1);
            if (rlx) { if constexpr (Epi::NST >= 16) PG8_WAIT_V(24); else PG8_WAIT_V(16); } else PG8_WAIT_V(8);
            PG8_WAIT_L(0); PG8_BAR; PG8_MMA(0, 0, At, B0); PG8_MMA(0, 1, At, B1); PG8_BAR; PG8_SCHED;
            PG8_LDA(At, 0, 1); PG8_STAGE_B(PG8_SB(0, 0), b2, 0, k2); PG8_STAGE_B(PG8_SB(0, 1), b2, 1, k2); PG8_STAGE_A(PG8_SA(0, 0), a2, a2o, 0, k2);
            if (rlx) { if constexpr (Epi::NST >= 16) PG8_WAIT_V(24); else PG8_WAIT_V(16); } else PG8_WAIT_V(8);
            PG8_WAIT_L(0); PG8_BAR; PG8_MMA(1, 0, At, B0); PG8_MMA(1, 1, At, B1); PG8_BAR; PG8_SCHED;
            PG8_LDB(B0, 1, 0); PG8_LDB(B1, 1, 1); PG8_SCHED; PG8_LDA(At, 1, 0); PG8_STAGE_A(PG8_SA(0, 1), a2, a2o, 1, k2);
            PG8_WAIT_V(8); PG8_WAIT_L(0); PG8_BAR; PG8_MMA(0, 0, At, B0); PG8_MMA(0, 1, At, B1); PG8_BAR; PG8_SCHED;
            PG8_LDA(At, 1, 1); PG8_STAGE_B(PG8_SB(1, 0), b2, 0, k3); PG8_STAGE_B(PG8_SB(1, 1), b2, 1, k3); PG8_STAGE_A(PG8_SA(1, 0), a2, a2o, 0, k3);
            PG8_WAIT_V(8); PG8_WAIT_L(0); PG8_BAR; PG8_MMA(1, 0, At, B0); PG8_MMA(1, 1, At, B1); PG8_BAR; PG8_SCHED;
            } else {
            PG8_LDB(B0, 0, 0); PG8_SCHED; PG8_LDA(At, 0, 0); PG8_STAGE_A(PG8_SA(1, 1), cA, cAo, 1, k1);
            PG8_WAIT_L(8); PG8_BAR; PG8_WAIT_L(0); PG8_MMA(0, 0, At, B0); PG8_BAR; PG8_SCHED;
            PG8_LDB(B1, 0, 1); PG8_STAGE_B(PG8_SB(0, 0), b2, 0, k2);
            PG8_BAR; PG8_WAIT_L(0); PG8_MMA(0, 1, At, B1); PG8_BAR;
            PG8_LDA(At, 0, 1); PG8_STAGE_A(PG8_SA(0, 0), a2, a2o, 0, k2);
            PG8_BAR; PG8_WAIT_L(0); PG8_MMA(1, 0, At, B0); PG8_BAR; PG8_SCHED;
            PG8_STAGE_B(PG8_SB(0, 1), b2, 1, k2);
            PG8_WAIT_V(6); PG8_BAR; PG8_MMA(1, 1, At, B1); PG8_BAR;
            PG8_LDB(B0, 1, 0); PG8_SCHED; PG8_LDA(At, 1, 0); PG8_STAGE_A(PG8_SA(0, 1), a2, a2o, 1, k2);
            PG8_WAIT_L(8); PG8_BAR; PG8_WAIT_L(0); PG8_MMA(0, 0, At, B0); PG8_BAR; PG8_SCHED;
            PG8_LDB(B1, 1, 1); PG8_STAGE_B(PG8_SB(1, 0), b2, 0, k3);
            PG8_BAR; PG8_WAIT_L(0); PG8_MMA(0, 1, At, B1); PG8_BAR;
            PG8_LDA(At, 1, 1); PG8_STAGE_A(PG8_SA(1, 0), a2, a2o, 0, k3);
            PG8_BAR; PG8_WAIT_L(0); PG8_MMA(1, 0, At, B0); PG8_BAR; PG8_SCHED;
            PG8_STAGE_B(PG8_SB(1, 1), b2, 1, k3);
            PG8_WAIT_V(6); PG8_BAR; PG8_MMA(1, 1, At, B1); PG8_BAR;
            }
        }
        if (wr == 0) PG8_BAR;
        E(acc, cur, wr, wc, fr, fq);
        if constexpr (Epi::DUPE) { asm volatile("" ::: "memory"); E(acc, cur, wr, wc, fr, fq); }
        if (!has_next) break;
#pragma unroll
        for (int a = 0; a < 2; ++a)
#pragma unroll
            for (int b = 0; b < 2; ++b)
#pragma unroll
                for (int m = 0; m < 4; ++m)
#pragma unroll
                    for (int n = 0; n < 2; ++n) acc[a][b][m][n] = (f32x4){0.f, 0.f, 0.f, 0.f};
        cur = nxt; cA = nA; cB = nB; ++ui;
        if constexpr (Sched::GATHER) {
#pragma unroll
            for (int h = 0; h < 2; ++h)
#pragma unroll
                for (int i = 0; i < 2; ++i) cAo[h][i] = nAo[h][i];
        }
        if (wr == 1) PG8_BAR;
    }
    PG8_WAIT_V(0);
    PG8_BAR;
#undef PG8_SA
#undef PG8_SB
#undef PG8_STAGE_A
#undef PG8_STAGE_B
#undef PG8_LDA
#undef PG8_LDB
#undef PG8_MMA
#undef PG8_WAIT_V
#undef PG8_WAIT_L
#undef PG8_BAR
#undef PG8_SCHED
}
}

struct Args { const float* in[32]; float* out; unsigned char* ws; int ph_lo, ph_hi; };
enum { I_X = 0, I_C, I_ADAW, I_ADAB, I_MIXNW, I_WIN, I_MU, I_W0, I_WUP, I_A0, I_AUP, I_GUP, I_KK, I_KA, I_RK, I_GNW, I_GNB, I_CONVW, I_CONVB, I_IB, I_FB, I_HNW, I_WOUT, I_FFNNW,
       I_WGRP, I_BGRP, I_WRT, I_BRT, I_WGATE, I_WUPE, I_WDOWN, I_FINW };

struct Frame {
    LAS unsigned char* lds;
    const float* const* in; float* out; unsigned char* ws;
    int tid, lane, wave, bid, G;
};

__device__ __forceinline__ void p0_transpose_item(const float* W, int ldw, int K, int k0, int ncol0, bf16_t* WT, int drow0, LAS float* scr, int lane) {
#pragma unroll 8
    for (int i = 0; i < 32; ++i) { const int kk = 2 * i + (lane >> 5); scr[kk * 33 + (lane & 31)] = W[(size_t)(k0 + kk) * ldw + ncol0 + (lane & 31)]; }
    LDS_WAIT(); asm volatile("" ::: "memory");
    const int c = lane & 7;
#pragma unroll
    for (int j = 0; j < 4; ++j) { const int n = (lane >> 3) + 8 * j; const LAS float* s = scr + (8 * c) * 33 + n;
        u32x4 o; o.x = cvt_pk_bf16(s[0 * 33], s[1 * 33]); o.y = cvt_pk_bf16(s[2 * 33], s[3 * 33]); o.z = cvt_pk_bf16(s[4 * 33], s[5 * 33]); o.w = cvt_pk_bf16(s[6 * 33], s[7 * 33]);
        *(u32x4*)(WT + (size_t)(drow0 + n) * K + k0 + 8 * c) = o; }
    LDS_WAIT(); asm volatile("" ::: "memory");
}
__device__ __forceinline__ void p0_tr_plain(const float* W, int ldw, int K, int N, bf16_t* WT, int r, LAS float* scr, int lane) {
    const int nblk = N / 32, kb = r / nblk, nb = r % nblk;
    p0_transpose_item(W, ldw, K, 64 * kb, 32 * nb, WT, 32 * nb, scr, lane);
}
__device__ __forceinline__ void p0_prologue(Frame& F) {
    const float* c = F.in[I_C]; const float* ada_w = F.in[I_ADAW]; const float* ada_b = F.in[I_ADAB];
    float* mod = (float*)(F.ws + WS_MOD);
    if (F.bid < 96) {
        constexpr int LDWm = 72, LDSm = 136;
        LAS bf16_t* Wh = (LAS bf16_t*)F.lds;
        LAS bf16_t* Wl = Wh + 128 * LDWm;
        LAS bf16_t* Sh = Wl + 128 * LDWm;
        LAS bf16_t* Sl = Sh + 32 * LDSm;
        const int col0 = F.bid * 64;
        const int wk = F.tid >> 2, wq = F.tid & 3;
        const int sb = F.tid >> 4, sk = (F.tid & 15) * 8;
        const int fr = F.lane & 15, fq = F.lane >> 4;
        const int mtm = F.wave >> 1, ntm = F.wave & 1;
        f32x4 accm = {0.f, 0.f, 0.f, 0.f};
        f32x4 wreg[4], creg[2];
#define MOD_LOAD(KC) do { const float* wp_ = ada_w + (size_t)((KC) * 128 + wk) * 6144 + col0 + wq * 16; \
            _Pragma("unroll") for (int q_ = 0; q_ < 4; ++q_) wreg[q_] = *(const f32x4*)(wp_ + 4 * q_); \
            const float* cp_ = c + sb * 1024 + (KC) * 128 + sk; creg[0] = *(const f32x4*)cp_; creg[1] = *(const f32x4*)(cp_ + 4); } while (0)
        MOD_LOAD(0);
#pragma unroll 1
        for (int kc = 0; kc < 8; ++kc) {
            __syncthreads();
            { float wv[16];
#pragma unroll
              for (int q = 0; q < 4; ++q) { wv[4 * q] = wreg[q].x; wv[4 * q + 1] = wreg[q].y; wv[4 * q + 2] = wreg[q].z; wv[4 * q + 3] = wreg[q].w; }
              unsigned ph[8], pl[8];
#pragma unroll
              for (int q = 0; q < 8; ++q) { const unsigned h2 = cvt_pk_bf16(wv[2 * q], wv[2 * q + 1]); ph[q] = h2; pl[q] = cvt_pk_bf16(wv[2 * q] - bf_lo(h2), wv[2 * q + 1] - bf_hi(h2)); }
              *(LAS u32x4*)(Wh + wk * LDWm + wq * 16) = (u32x4){ph[0], ph[1], ph[2], ph[3]}; *(LAS u32x4*)(Wh + wk * LDWm + wq * 16 + 8) = (u32x4){ph[4], ph[5], ph[6], ph[7]};
              *(LAS u32x4*)(Wl + wk * LDWm + wq * 16) = (u32x4){pl[0], pl[1], pl[2], pl[3]}; *(LAS u32x4*)(Wl + wk * LDWm + wq * 16 + 8) = (u32x4){pl[4], pl[5], pl[6], pl[7]};
              float sv[8] = {creg[0].x, creg[0].y, creg[0].z, creg[0].w, creg[1].x, creg[1].y, creg[1].z, creg[1].w};
              unsigned qh[4], ql[4];
#pragma unroll
              for (int q = 0; q < 8; ++q) sv[q] = sv[q] / (1.0f + __expf(-sv[q]));
#pragma unroll
              for (int q = 0; q < 4; ++q) { const unsigned h2 = cvt_pk_bf16(sv[2 * q], sv[2 * q + 1]); qh[q] = h2; ql[q] = cvt_pk_bf16(sv[2 * q] - bf_lo(h2), sv[2 * q + 1] - bf_hi(h2)); }
              *(LAS u32x4*)(Sh + sb * LDSm + sk) = (u32x4){qh[0], qh[1], qh[2], qh[3]}; *(LAS u32x4*)(Sl + sb * LDSm + sk) = (u32x4){ql[0], ql[1], ql[2], ql[3]}; }
            if (kc + 1 < 8) MOD_LOAD(kc + 1);
            __syncthreads();
#pragma unroll
            for (int ks = 0; ks < 4; ++ks) {
                bf16x8 ah, al;
                { const LAS bf16_t* p_ = Wh + (ks * 32 + 8 * fq + (fr >> 2)) * LDWm + 16 * mtm + 4 * (fr & 3);
                  const s16x4 lo_ = __builtin_amdgcn_ds_read_tr16_b64_v4i16((LAS s16x4*)p_), hi_ = __builtin_amdgcn_ds_read_tr16_b64_v4i16((LAS s16x4*)(p_ + 4 * LDWm)); ah = __builtin_shufflevector(lo_, hi_, 0, 1, 2, 3, 4, 5, 6, 7); }
                { const LAS bf16_t* p_ = Wl + (ks * 32 + 8 * fq + (fr >> 2)) * LDWm + 16 * mtm + 4 * (fr & 3);
                  const s16x4 lo_ = __builtin_amdgcn_ds_read_tr16_b64_v4i16((LAS s16x4*)p_), hi_ = __builtin_amdgcn_ds_read_tr16_b64_v4i16((LAS s16x4*)(p_ + 4 * LDWm)); al = __builtin_shufflevector(lo_, hi_, 0, 1, 2, 3, 4, 5, 6, 7); }
                const bf16x8 bh = *(const LAS bf16x8*)(Sh + (ntm * 16 + fr) * LDSm + ks * 32 + fq * 8), bl = *(const LAS bf16x8*)(Sl + (ntm * 16 + fr) * LDSm + ks * 32 + fq * 8);
                accm = __builtin_amdgcn_mfma_f32_16x16x32_bf16(ah, bh, accm, 0, 0, 0);
                accm = __builtin_amdgcn_mfma_f32_16x16x32_bf16(ah, bl, accm, 0, 0, 0);
                accm = __builtin_amdgcn_mfma_f32_16x16x32_bf16(al, bh, accm, 0, 0, 0);
            }
        }
#undef MOD_LOAD
        { const int colw = col0 + mtm * 16 + fq * 4, bw = ntm * 16 + fr;
          const f32x4 bb = *(const f32x4*)(ada_b + colw);
          *(f32x4*)(mod + (size_t)bw * 6144 + colw) = accm + bb; }
        __syncthreads();
    }
    LAS float* scr = (LAS float*)(F.lds + F.wave * 16384);
    const int gw = F.bid * NWAVES + F.wave, NGW = F.G * NWAVES;
    bf16_t* WINT = (bf16_t*)(F.ws + WS_WIN); bf16_t* WOUTT = (bf16_t*)(F.ws + WS_WOUT); bf16_t* W1T = (bf16_t*)(F.ws + WS_W1); bf16_t* W2T = (bf16_t*)(F.ws + WS_W2);
    bf16_t* WUPT = (bf16_t*)(F.ws + WS_LORA); bf16_t* AUPT = WUPT + 512 * 64; bf16_t* GUPT = AUPT + 512 * 64;
    constexpr int I_IN = 16 * 104, I_OUT = 16 * 32, I_G = 32 * 16 * 8, I_U = I_G, I_D = 32 * 4 * 32, I_L1 = 16, I_L2 = 16, I_L3 = 32;
    constexpr int NITEMS = I_IN + I_OUT + I_G + I_U + I_D + I_L1 + I_L2 + I_L3;
    for (int it = gw; it < NITEMS; it += NGW) {
        int r = it;
        if (r < I_IN) { p0_tr_plain(F.in[I_WIN], IN_COLS, 1024, NPROJ, WINT, r, scr, F.lane); continue; } r -= I_IN;
        if (r < I_OUT) { p0_tr_plain(F.in[I_WOUT], 1024, 1024, 1024, WOUTT, r, scr, F.lane); continue; } r -= I_OUT;
        if (r < I_G + I_U) {
            const int isup = r >= I_G; if (isup) r -= I_G;
            const int e = r / 128, rr = r % 128, kb = rr / 8, nb = rr % 8;
            const float* W = (isup ? F.in[I_WUPE] : F.in[I_WGATE]) + (size_t)e * 1024 * 256;
            const int f0 = 32 * nb, drow0 = (f0 >> 7) * 256 + (isup ? 128 : 0) + (f0 & 127);
            p0_transpose_item(W, 256, 1024, 64 * kb, f0, W1T + (size_t)e * 512 * 1024, drow0, scr, F.lane); continue; }
        r -= I_G + I_U;
        if (r < I_D) { const int e = r / 128, rr = r % 128; p0_tr_plain(F.in[I_WDOWN] + (size_t)e * 256 * 1024, 1024, 256, 1024, W2T + (size_t)e * 1024 * 256, rr, scr, F.lane); continue; } r -= I_D;
        if (r < I_L1) { p0_tr_plain(F.in[I_WUP], 512, 64, 512, WUPT, r, scr, F.lane); continue; } r -= I_L1;
        if (r < I_L2) { p0_tr_plain(F.in[I_AUP], 512, 64, 512, AUPT, r, scr, F.lane); continue; } r -= I_L2;
        p0_tr_plain(F.in[I_GUP], 512, 128, 512, GUPT, r, scr, F.lane);
    }
}

__device__ __forceinline__ void p1_norm1(Frame& F) {
    const float* x = F.in[I_X]; const float* nw = F.in[I_MIXNW]; const float* win = F.in[I_WIN];
    const float* mod = (const float*)(F.ws + WS_MOD);
    bf16_t* H = (bf16_t*)(F.ws + WS_H); float* gates = (float*)(F.ws + WS_GATES);
    LAS float* gwl = (LAS float*)F.lds;
    for (int i = F.tid; i < 8 * 1024; i += NTHR) { const int g = i & 7, k = i >> 3; gwl[g * 1024 + k] = win[(size_t)k * IN_COLS + NPROJ + g]; }
    __syncthreads();
    const int gw = F.bid * NWAVES + F.wave;
    const int b = gw >> 6; const int r0 = b * SEQ + (gw & 63);
    f32x4 g1v[4], shv[4];
#pragma unroll
    for (int j = 0; j < 4; ++j) { const f32x4 n4 = *(const f32x4*)(nw + 4 * F.lane + 256 * j), sc = *(const f32x4*)(mod + b * 6144 + 1024 + 4 * F.lane + 256 * j);
        g1v[j] = n4 * (sc + 1.0f); shv[j] = *(const f32x4*)(mod + b * 6144 + 4 * F.lane + 256 * j); }
    f32x4 xn[4];
    if (gw < NB * 64) { const float* xr0 = x + (size_t)r0 * D + 4 * F.lane;
#pragma unroll
        for (int j = 0; j < 4; ++j) xn[j] = *(const f32x4*)(xr0 + 256 * j); }
    for (int i = 0; i < 32 && gw < NB * 64; ++i) {
        const int m = r0 + 64 * i;
        f32x4 v[4]; float ss = 0.f;
#pragma unroll
        for (int j = 0; j < 4; ++j) { v[j] = xn[j]; ss += (v[j].x * v[j].x + v[j].y * v[j].y) + (v[j].z * v[j].z + v[j].w * v[j].w); }
        if (i + 1 < 32) { const float* xr1 = x + (size_t)(m + 64) * D + 4 * F.lane;
#pragma unroll
            for (int j = 0; j < 4; ++j) xn[j] = *(const f32x4*)(xr1 + 256 * j); }
        ss = wave_sum(ss);
        const float rstd = __builtin_amdgcn_rsqf(ss * (1.0f / D) + 1e-6f);
        float g8[8];
#pragma unroll
        for (int g = 0; g < 8; ++g) g8[g] = 0.f;
#pragma unroll
        for (int j = 0; j < 4; ++j) {
            f32x4 hv = (v[j] * rstd) * g1v[j] + shv[j];
            v[j] = hv;
#pragma unroll
            for (int g = 0; g < 8; ++g) { const f32x4 w = *(const LAS f32x4*)(gwl + g * 1024 + 4 * F.lane + 256 * j); g8[g] += (hv.x * w.x + hv.y * w.y) + (hv.z * w.z + hv.w * w.w); }
        }
        u32x2* o = (u32x2*)(H + (size_t)m * D + 4 * F.lane);
#pragma unroll
        for (int j = 0; j < 4; ++j) { u32x2 w; w.x = cvt_pk_bf16(v[j].x, v[j].y); w.y = cvt_pk_bf16(v[j].z, v[j].w); o[64 * j] = w; }
#pragma unroll
        for (int g = 0; g < 8; ++g) g8[g] = wave_sum_l63(g8[g]);
        if (F.lane == 63) { *(f32x4*)(gates + (size_t)m * 8) = (f32x4){g8[0], g8[1], g8[2], g8[3]}; *(f32x4*)(gates + (size_t)m * 8 + 4) = (f32x4){g8[4], g8[5], g8[6], g8[7]}; }
    }
}

template <int K> struct DenseOrder {
    static constexpr bool GATHER = false;
    const char* A; const char* Bt; int nM, nN, nwg, G, c, wgm;
    __device__ __forceinline__ void init(const void* A_, const void* Bt_, int M, int N, int G_, int c_, int wgm_ = 8) { A = (const char*)A_; Bt = (const char*)Bt_; nM = M / 256; nN = N / 256; nwg = nM * nN; G = G_; c = c_; wgm = wgm_; }
    __device__ __forceinline__ bool next(int i, pg8::Unit& u) const {
        const int L = i * G + c; if (L >= nwg) return false;
        const int wgid = pg8::xcd_remap(L, nwg);
        const int nig = wgm * nN, gid = wgid / nig, fm = gid * wgm, gsz = (nM - fm) < wgm ? (nM - fm) : wgm;
        u.pm = fm + ((wgid % nig) % gsz); u.pn = (wgid % nig) / gsz; u.e = 0; return true;
    }
    __device__ __forceinline__ const char* a_base(const pg8::Unit& u) const { return A + (size_t)u.pm * 256 * K * 2; }
    __device__ __forceinline__ const char* b_base(const pg8::Unit& u) const { return Bt + (size_t)u.pn * 256 * K * 2; }
    __device__ __forceinline__ unsigned a_rowoff(const pg8::Unit&, int) const { return 0u; }
};
struct EpiProj {
    static constexpr bool PERM = true; static constexpr bool DUPE = (MK_DUP == 60); static constexpr int NST = 16;
    bf16_t* O;
    __device__ __forceinline__ void operator()(const f32x4 (&acc)[2][2][4][2], const pg8::Unit& u, int wr, int wc, int fr, int fq) const {
        const int row0 = u.pm * 256 + wr * 64 + fr, col0 = u.pn * 256 + wc * 32 + 8 * fq;
#pragma unroll
        for (int ai = 0; ai < 2; ++ai)
#pragma unroll
            for (int m = 0; m < 4; ++m) { bf16_t* rowp = O + (size_t)(row0 + ai * 128 + m * 16) * NPROJ + col0;
#pragma unroll
                for (int bj = 0; bj < 2; ++bj) { const f32x4 v0 = acc[ai][bj][m][0], v1 = acc[ai][bj][m][1];
                    u32x4 w; w.x = cvt_pk_bf16(v0[0], v0[1]); w.y = cvt_pk_bf16(v0[2], v0[3]); w.z = cvt_pk_bf16(v1[0], v1[1]); w.w = cvt_pk_bf16(v1[2], v1[3]);
                    *(u32x4*)(rowp + bj * 128) = w; } }
    }
};
struct EpiOut {
    static constexpr bool PERM = true; static constexpr bool DUPE = (MK_DUP == 61); static constexpr int NST = 16;
    const float* x; const float* mod; bf16_t* x1;
    __device__ __forceinline__ void operator()(const f32x4 (&acc)[2][2][4][2], const pg8::Unit& u, int wr, int wc, int fr, int fq) const {
        const int row0 = u.pm * 256 + wr * 64 + fr, col0 = u.pn * 256 + wc * 32 + 8 * fq;
        const int b = u.pm >> 3;
        f32x4 gm[2][2];
#pragma unroll
        for (int bj = 0; bj < 2; ++bj)
#pragma unroll
            for (int n = 0; n < 2; ++n) gm[bj][n] = *(const f32x4*)(mod + b * 6144 + 2048 + col0 + bj * 128 + n * 4);
#pragma unroll
        for (int ai = 0; ai < 2; ++ai)
#pragma unroll
            for (int m = 0; m < 4; ++m) { const size_t off = (size_t)(row0 + ai * 128 + m * 16) * D + col0;
#pragma unroll
                for (int bj = 0; bj < 2; ++bj) { const f32x4 x0 = *(const f32x4*)(x + off + bj * 128), x4 = *(const f32x4*)(x + off + bj * 128 + 4);
                    const f32x4 v0 = x0 + gm[bj][0] * acc[ai][bj][m][0], v1 = x4 + gm[bj][1] * acc[ai][bj][m][1];
                    u32x4 w; w.x = cvt_pk_bf16(v0[0], v0[1]); w.y = cvt_pk_bf16(v0[2], v0[3]); w.z = cvt_pk_bf16(v1[0], v1[1]); w.w = cvt_pk_bf16(v1[2], v1[3]);
                    *(u32x4*)(x1 + off + bj * 128) = w; } }
    }
};
struct MoeTab { const LAS int* tile_e; int ntiles; };
struct GateUpOrder {
    static constexpr bool GATHER = true;
    const char* A; const char* W1; const u32x2* slot; MoeTab tab; int nwg, G, c;
    __device__ __forceinline__ bool next(int i, pg8::Unit& u) const {
        const int L = i * G + c; if (L >= nwg) return false;
        const int w = pg8::xcd_remap(L, nwg); u.pm = w >> 1; u.pn = w & 1; u.e = tab.tile_e[u.pm]; return true;
    }
    __device__ __forceinline__ const char* a_base(const pg8::Unit&) const { return A; }
    __device__ __forceinline__ const char* b_base(const pg8::Unit& u) const { return W1 + ((size_t)u.e * 512 + (size_t)u.pn * 256) * 1024 * 2; }
    __device__ __forceinline__ unsigned a_rowoff(const pg8::Unit& u, int r) const { const int tk = (int)slot[u.pm * 256 + r].x; const unsigned tok = tk < 0 ? 0u : ((unsigned)tk & 0xffffu); return tok * 2048u; }
};
struct EpiGateUp {
    static constexpr bool PERM = true; static constexpr bool DUPE = (MK_DUP == 62); static constexpr int NST = 8;
    bf16_t* Hact;
    __device__ __forceinline__ void operator()(const f32x4 (&acc)[2][2][4][2], const pg8::Unit& u, int wr, int wc, int fr, int fq) const {
        const int row0 = u.pm * 256 + wr * 64 + fr, col0 = u.pn * 128 + wc * 32 + 8 * fq;
#pragma unroll
        for (int ai = 0; ai < 2; ++ai)
#pragma unroll
            for (int m = 0; m < 4; ++m) { bf16_t* rowp = Hact + (size_t)(row0 + ai * 128 + m * 16) * 256 + col0;
                float o[8];
#pragma unroll
                for (int n = 0; n < 2; ++n)
#pragma unroll
                    for (int e = 0; e < 4; ++e) { const float g = acc[ai][0][m][n][e], up = acc[ai][1][m][n][e]; o[4 * n + e] = g * fsigmoid(g) * up; }
                u32x4 w; w.x = cvt_pk_bf16(o[0], o[1]); w.y = cvt_pk_bf16(o[2], o[3]); w.z = cvt_pk_bf16(o[4], o[5]); w.w = cvt_pk_bf16(o[6], o[7]);
                *(u32x4*)rowp = w; }
    }
};
struct DownOrder {
    static constexpr bool GATHER = false;
    const char* A; const char* W2; MoeTab tab; int nwg, G, c;
    __device__ __forceinline__ bool next(int i, pg8::Unit& u) const {
        const int L = i * G + c; if (L >= nwg) return false;
        const int w = pg8::xcd_remap(L, nwg); u.pm = w >> 2; u.pn = w & 3; u.e = tab.tile_e[u.pm]; return true;
    }
    __device__ __forceinline__ const char* a_base(const pg8::Unit& u) const { return A + (size_t)u.pm * 256 * 256 * 2; }
    __device__ __forceinline__ const char* b_base(const pg8::Unit& u) const { return W2 + ((size_t)u.e * 1024 + (size_t)u.pn * 256) * 256 * 2; }
    __device__ __forceinline__ unsigned a_rowoff(const pg8::Unit&, int) const { return 0u; }
};
struct EpiDown {
    static constexpr bool PERM = true; static constexpr bool DUPE = (MK_DUP == 63); static constexpr int NST = 16;
    bf16_t* moes;
    __device__ __forceinline__ void operator()(const f32x4 (&acc)[2][2][4][2], const pg8::Unit& u, int wr, int wc, int fr, int fq) const {
        const int row0 = u.pm * 256 + wr * 64 + fr, col0 = u.pn * 256 + wc * 32 + 8 * fq;
#pragma unroll
        for (int ai = 0; ai < 2; ++ai)
#pragma unroll
            for (int m = 0; m < 4; ++m) { bf16_t* rowp = moes + (size_t)(row0 + ai * 128 + m * 16) * D + col0;
#pragma unroll
                for (int bj = 0; bj < 2; ++bj) { const f32x4 v0 = acc[ai][bj][m][0], v1 = acc[ai][bj][m][1];
                    u32x4 w; w.x = cvt_pk_bf16(v0[0], v0[1]); w.y = cvt_pk_bf16(v0[2], v0[3]); w.z = cvt_pk_bf16(v1[0], v1[1]); w.w = cvt_pk_bf16(v1[2], v1[3]);
                    *(u32x4*)(rowp + bj * 128) = w; } }
    }
};

__device__ __forceinline__ void p3a_lin(Frame& F) {
    const bf16_t* proj = (const bf16_t*)(F.ws + WS_PROJ); bf16_t* LIN = (bf16_t*)(F.ws + WS_H);
    const int cv = F.tid & 31;
    float mu8[8];
#pragma unroll
    for (int q = 0; q < 8; ++q) mu8[q] = F.in[I_MU][C_WD + cv * 8 + q];
    const float al = cv < 8 ? 2.0f : 1.0f, be = cv < 8 ? 2.0f : 1.0f, ga = cv < 8 ? -1.0f : 0.f; const bool plain = cv >= 8 && cv < 16;
    const int v0 = F.bid * NTHR + F.tid, vstep = F.G * NTHR;
#pragma unroll 1
    for (int vb = v0; vb < T * 32; vb += 4 * vstep) {
        u32x4 pc[4], pp[4];
#pragma unroll
        for (int i = 0; i < 4; ++i) { const int v = vb + i * vstep; const int t = v >> 5; pc[i] = (u32x4){0u, 0u, 0u, 0u}; pp[i] = pc[i];
            if (v < T * 32) { const bf16_t* row = proj + (size_t)t * NPROJ + C_WD + cv * 8; pc[i] = *(const u32x4*)row; if ((t & (SEQ - 1)) != 0) pp[i] = *(const u32x4*)(row - NPROJ); } }
#pragma unroll
        for (int i = 0; i < 4; ++i) { const int v = vb + i * vstep; const int t = v >> 5;
            float u[8];
#pragma unroll
            for (int q = 0; q < 4; ++q) { const float c0 = bf_lo(pc[i][q]), c1 = bf_hi(pc[i][q]), p0 = bf_lo(pp[i][q]), p1 = bf_hi(pp[i][q]);
                u[2 * q] = c0 + (p0 - c0) * mu8[2 * q]; u[2 * q + 1] = c1 + (p1 - c1) * mu8[2 * q + 1]; }
#pragma unroll
            for (int q = 0; q < 8; ++q) { const float sg = al * fsigmoid(be * u[q]) + ga; u[q] = plain ? u[q] : sg; }
            u32x4 w; w.x = cvt_pk_bf16(u[0], u[1]); w.y = cvt_pk_bf16(u[2], u[3]); w.z = cvt_pk_bf16(u[4], u[5]); w.w = cvt_pk_bf16(u[6], u[7]);
            if (v < T * 32) *(u32x4*)(LIN + (size_t)t * 256 + cv * 8) = w; }
    }
}

namespace rk {
constexpr int LD = 72;
constexpr int SLOT = 64 * LD * 2;
__device__ __forceinline__ bf16x8 frag(const LAS bf16_t* M, int row, int k) { return *(const LAS bf16x8*)(M + row * LD + k); }
__device__ __forceinline__ f32x4 mma(bf16x8 a, bf16x8 b, f32x4 c) { return __builtin_amdgcn_mfma_f32_16x16x32_bf16(a, b, c, 0, 0, 0); }
__device__ __forceinline__ void storeT(LAS bf16_t* Out, int mt, int nt, int fr, int fq, f32x4 v) {
    u32x2 w; w.x = cvt_pk_bf16(v[0], v[1]); w.y = cvt_pk_bf16(v[2], v[3]); *(LAS u32x2*)(Out + (nt * 16 + fr) * LD + mt * 16 + fq * 4) = w; }
__device__ __forceinline__ void storeRM(LAS bf16_t* Out, int mt, int nt, int fr, int fq, f32x4 v) {
#pragma unroll
    for (int r = 0; r < 4; ++r) Out[(mt * 16 + fq * 4 + r) * LD + nt * 16 + fr] = f2bf(v[r]); }
}
__device__ __forceinline__ void p3_rwkv_chunked(Frame& F) {
    using namespace rk;
    if (F.bid >= 256) return;
    const int b = F.bid >> 3, h = F.bid & 7;
    const bf16_t* proj = (const bf16_t*)(F.ws + WS_PROJ) + (size_t)b * SEQ * NPROJ;
    bf16_t* mix = (bf16_t*)(F.ws + WS_MIX) + (size_t)b * SEQ * D + h * 64;
    LAS unsigned char* L = F.lds;
#define RSLOT(i) ((LAS bf16_t*)(L + (i) * SLOT))
    LAS bf16_t* Sst = RSLOT(0);  LAS bf16_t* GG = RSLOT(1);
    LAS float* AabF = (LAS float*)RSLOT(2);
    LAS bf16_t* U0T = RSLOT(2);  LAS bf16_t* Gy = RSLOT(3);
    LAS bf16_t* AA = RSLOT(4);   LAS bf16_t* Aab = RSLOT(4); LAS bf16_t* MT = RSLOT(4);
    LAS bf16_t* At = RSLOT(5);   LAS bf16_t* Aw = RSLOT(5);
    LAS bf16_t* Bt = RSLOT(6);   LAS bf16_t* Ag = RSLOT(6);
    LAS bf16_t* Kt = RSLOT(7);
    LAS bf16_t* WT = RSLOT(8);
    LAS bf16_t* Rt = RSLOT(9);   LAS bf16_t* Aa = RSLOT(9);
    LAS bf16_t* PT = RSLOT(10);  LAS bf16_t* EB = RSLOT(10); LAS float* Yf = (LAS float*)RSLOT(10);
    LAS bf16_t* Tm = RSLOT(11);
    LAS bf16_t* Vm = RSLOT(12);
    LAS bf16_t* Aak = RSLOT(13); LAS float* LAMf = (LAS float*)RSLOT(13);
    LAS bf16_t* LWh = RSLOT(2); LAS bf16_t* LWl = RSLOT(3);
    LAS bf16_t* Arb = RSLOT(14); LAS bf16_t* Ark = RSLOT(15);
#undef RSLOT
    (void)Aw; (void)Aa; (void)Ag;
    LAS float* mu = (LAS float*)(L + 16 * SLOT);
    LAS float* prm = mu + 448;
    LAS float* bonus = prm + 448;
    LAS float* gL = bonus + 64;
    LAS float* et = (LAS float*)(L + MISC_OFF + 1024);
    LAS float* H0 = (LAS float*)(L + 155648);
    for (int i = F.tid; i < 448; i += NTHR) {
        int col; if (i < 64) col = C_R + h * 64 + i; else if (i < 128) col = C_K + h * 64 + (i - 64); else if (i < 192) col = C_V + h * 64 + (i - 128); else col = C_WD + (i - 192);
        mu[i] = F.in[I_MU][col]; }
    for (int i = F.tid; i < 448; i += NTHR) { const int w = i >> 6, j = i & 63;
        const float* src = w == 0 ? F.in[I_W0] : w == 1 ? F.in[I_A0] : w == 2 ? F.in[I_KK] : w == 3 ? F.in[I_KA] : w == 4 ? F.in[I_RK] : w == 5 ? F.in[I_GNW] : F.in[I_GNB];
        prm[i] = src[h * 64 + j]; }
    for (int i = F.tid; i < SLOT / 4; i += NTHR) ((LAS unsigned*)Sst)[i] = 0u;
    const int mt = F.wave >> 1, nt0 = (F.wave & 1) * 2;
#define RK_IDS() int tidv_ = F.tid; asm volatile("" : "+v"(tidv_)); const int lanev_ = tidv_ & 63; const int fr = lanev_ & 15, fq = lanev_ >> 4; const int tq = tidv_ >> 3, seg = tidv_ & 7, j0 = seg * 8; (void)fr; (void)fq; (void)tq; (void)seg; (void)j0
#define FRN(M, row, k) (*(const LAS bf16x8*)((M) + (row) * LD + (k)))
#define FRT(dst, M, k0, c0) do { const LAS bf16_t* p_ = (M) + ((k0) + 8 * fq + (fr >> 2)) * LD + (c0) + 4 * (fr & 3); \
        const s16x4 lo_ = __builtin_amdgcn_ds_read_tr16_b64_v4i16((LAS s16x4*)p_); const s16x4 hi_ = __builtin_amdgcn_ds_read_tr16_b64_v4i16((LAS s16x4*)(p_ + 4 * LD)); \
        dst = __builtin_shufflevector(lo_, hi_, 0, 1, 2, 3, 4, 5, 6, 7); } while (0)
    bf16x8 wlw[2][2], wla[2][2], wlg[2][4];
    { RK_IDS();
      const bf16_t* WUPT = (const bf16_t*)(F.ws + WS_LORA) + (size_t)h * 64 * 64; const bf16_t* AUPT = (const bf16_t*)(F.ws + WS_LORA) + 512 * 64 + (size_t)h * 64 * 64;
      const bf16_t* GUPT = (const bf16_t*)(F.ws + WS_LORA) + 2 * 512 * 64 + (size_t)h * 64 * 128;
#pragma unroll
      for (int jn = 0; jn < 2; ++jn) { const int n = (nt0 + jn) * 16 + fr;
#pragma unroll
          for (int ks = 0; ks < 2; ++ks) { wlw[jn][ks] = *(const bf16x8*)(WUPT + (size_t)n * 64 + ks * 32 + fq * 8); wla[jn][ks] = *(const bf16x8*)(AUPT + (size_t)n * 64 + ks * 32 + fq * 8); }
#pragma unroll
          for (int ks = 0; ks < 4; ++ks) wlg[jn][ks] = *(const bf16x8*)(GUPT + (size_t)n * 128 + ks * 32 + fq * 8); } }
    const bf16_t* LINb = (const bf16_t*)(F.ws + WS_H) + (size_t)b * SEQ * 256;
    u32x4 pf[14];
#define RK_LOADS(T0N) do { RK_IDS(); const int t_ = (T0N) + tq; const bf16_t* row_ = proj + (size_t)t_ * NPROJ; const bool hp_ = t_ > 0; const u32x4 z_ = {0u, 0u, 0u, 0u}; \
        _Pragma("unroll") for (int w3 = 0; w3 < 3; ++w3) { const int col_ = (w3 == 0 ? C_R : w3 == 1 ? C_K : C_V) + h * 64 + j0; pf[w3] = *(const u32x4*)(row_ + col_); pf[3 + w3] = z_; if (hp_) pf[3 + w3] = *(const u32x4*)(row_ - NPROJ + col_); } \
        const bf16_t* lr_ = LINb + (size_t)((T0N) + mt * 16 + fr) * 256 + fq * 8; \
        _Pragma("unroll") for (int q8 = 0; q8 < 8; ++q8) pf[6 + q8] = *(const u32x4*)(lr_ + q8 * 32); } while (0)
    RK_LOADS(0);
    f32x4 sn[2] = {{0.f, 0.f, 0.f, 0.f}, {0.f, 0.f, 0.f, 0.f}};
    __syncthreads();
#pragma unroll 1
    for (int t0 = 0; t0 < SEQ; t0 += 64) {
        float r8[8], k8[8], v8[8], kk[8];
        {
            RK_IDS();
#pragma unroll
            for (int w3 = 0; w3 < 3; ++w3) {
                const u32x4 pc = pf[w3], pp = pf[3 + w3];
                const f32x4 m0 = *(const LAS f32x4*)(mu + w3 * 64 + j0), m1 = *(const LAS f32x4*)(mu + w3 * 64 + j0 + 4);
#pragma unroll
                for (int q = 0; q < 4; ++q) { const float c0 = bf_lo(pc[q]), c1 = bf_hi(pc[q]), p0 = bf_lo(pp[q]), p1 = bf_hi(pp[q]);
                    const float mu0 = q < 2 ? m0[2 * q] : m1[2 * q - 4], mu1 = q < 2 ? m0[2 * q + 1] : m1[2 * q - 3];
                    const float u0 = c0 + (p0 - c0) * mu0, u1 = c1 + (p1 - c1) * mu1;
                    if (w3 == 0) { r8[2 * q] = u0; r8[2 * q + 1] = u1; } else if (w3 == 1) { k8[2 * q] = u0; k8[2 * q + 1] = u1; } else { v8[2 * q] = u0; v8[2 * q + 1] = u1; } }
            }
            { const f32x4 c0 = *(const LAS f32x4*)(prm + 128 + j0), c1 = *(const LAS f32x4*)(prm + 128 + j0 + 4);
              float ss = 0.f;
#pragma unroll
              for (int q = 0; q < 8; ++q) { kk[q] = k8[q] * (q < 4 ? c0[q] : c1[q - 4]); ss += kk[q] * kk[q]; }
              ss = row8_sum(ss);
              const float inv = fminf(__builtin_amdgcn_rsqf(ss), 1e12f);
#pragma unroll
              for (int q = 0; q < 8; ++q) kk[q] *= inv; }
            { u32x4 w; w.x = cvt_pk_bf16(v8[0], v8[1]); w.y = cvt_pk_bf16(v8[2], v8[3]); w.z = cvt_pk_bf16(v8[4], v8[5]); w.w = cvt_pk_bf16(v8[6], v8[7]); *(LAS u32x4*)(Vm + tq * LD + j0) = w; }
#pragma unroll
            for (int q = 0; q < 8; ++q) asm volatile("" : "+v"(r8[q]), "+v"(k8[q]), "+v"(v8[q]), "+v"(kk[q]));
        }
        f32x4 cgk[2];
        for (int rp_ = 0; rp_ < (RKP == 7 ? 2 : 1); ++rp_) {
        { RK_IDS();
          bf16x8 tri4;
#pragma unroll
          for (int e = 0; e < 8; ++e) tri4[e] = (e < 4 && fq * 4 + e <= fr) ? (short)0x3F80 : (short)0;
#pragma unroll
        for (int jn = 0; jn < 2; ++jn) { const int nt = nt0 + jn; const int n = nt * 16 + fr;
            f32x4 cw = {0.f, 0.f, 0.f, 0.f}, ca = cw, cg = cw;
#pragma unroll
            for (int ks = 0; ks < 2; ++ks) {
                cw = mma(__builtin_bit_cast(bf16x8, pf[6 + ks]), wlw[jn][ks], cw);
                ca = mma(__builtin_bit_cast(bf16x8, pf[8 + ks]), wla[jn][ks], ca); }
#pragma unroll
            for (int ks = 0; ks < 4; ++ks) cg = mma(__builtin_bit_cast(bf16x8, pf[10 + ks]), wlg[jn][ks], cg);
            const float w0v = prm[n], a0v = prm[64 + n];
            float lwv[4];
#pragma unroll
            for (int r = 0; r < 4; ++r) { const int t = mt * 16 + fq * 4 + r;
                lwv[r] = -0.60653066f * fsigmoid(w0v + cw[r]);
                AA[t * LD + n] = f2bf(fsigmoid(a0v + ca[r])); }
            { u32x4 ph = {cvt_pk_bf16(lwv[0], lwv[1]), cvt_pk_bf16(lwv[2], lwv[3]), 0u, 0u};
              u32x4 pl = {cvt_pk_bf16(lwv[0] - bf_lo(ph.x), lwv[1] - bf_hi(ph.x)), cvt_pk_bf16(lwv[2] - bf_lo(ph.y), lwv[3] - bf_hi(ph.y)), 0u, 0u};
              f32x4 cl = {0.f, 0.f, 0.f, 0.f};
              cl = mma(tri4, __builtin_bit_cast(bf16x8, ph), cl); cl = mma(tri4, __builtin_bit_cast(bf16x8, pl), cl);
#pragma unroll
              for (int r = 0; r < 4; ++r) LAMf[(mt * 16 + fq * 4 + r) * LD + n] = __expf(cl[r]);
              if (fq == 3) et[mt * 64 + n] = __expf(cl[3]); }
            cgk[jn] = cg;
        } }
        if (RKP == 7 && rp_ == 0) __syncthreads(); }
        if (t0 + 64 < SEQ) { RK_LOADS(t0 + 64); if (RKP == 4) { __syncthreads(); RK_LOADS(t0 + 64); } }
        __syncthreads();
        for (int rp_ = 0; rp_ < (RKP == 9 ? 2 : 1); ++rp_) {
        {
            RK_IDS();
            float a8[8], lt[8], lp[8];
            { const u32x4 av = *(const LAS u32x4*)(AA + tq * LD + j0);
#pragma unroll
              for (int q = 0; q < 4; ++q) { a8[2 * q] = bf_lo(av[q]); a8[2 * q + 1] = bf_hi(av[q]); } }
            { const int tp = tq > 0 ? tq - 1 : 0;
              const f32x4 l0 = *(const LAS f32x4*)(LAMf + tq * LD + j0), l1 = *(const LAS f32x4*)(LAMf + tq * LD + j0 + 4), q0 = *(const LAS f32x4*)(LAMf + tp * LD + j0), q1 = *(const LAS f32x4*)(LAMf + tp * LD + j0 + 4);
              f32x4 p0 = {1.f, 1.f, 1.f, 1.f}, p1 = p0;
              const int mtile = F.wave >> 1;
              for (int mm = 0; mm < mtile; ++mm) { p0 *= *(const LAS f32x4*)(et + mm * 64 + j0); p1 *= *(const LAS f32x4*)(et + mm * 64 + j0 + 4); }
              const bool first = (tq & 15) == 0;
#pragma unroll
              for (int q = 0; q < 8; ++q) { const float pm = q < 4 ? p0[q] : p1[q - 4]; lt[q] = (q < 4 ? l0[q] : l1[q - 4]) * pm; const float pv = (q < 4 ? q0[q] : q1[q - 4]) * pm; lp[q] = first ? pm : pv; }
              if (tq == 63) {
#pragma unroll
                  for (int q = 0; q < 8; ++q) gL[j0 + q] = lt[q]; } }
            { const int mtc = F.wave >> 1, ntc = (F.wave & 1) * 2;
#pragma unroll
              for (int jn = 0; jn < 2; ++jn)
#pragma unroll
                  for (int r = 0; r < 4; ++r) GG[(mtc * 16 + fq * 4 + r) * LD + (ntc + jn) * 16 + fr] = f2bf(cgk[jn][r]); }
            float kp[8], bs = 0.f;
            { const f32x4 ka0 = *(const LAS f32x4*)(prm + 192 + j0), ka1 = *(const LAS f32x4*)(prm + 192 + j0 + 4), rk0 = *(const LAS f32x4*)(prm + 256 + j0), rk1 = *(const LAS f32x4*)(prm + 256 + j0 + 4);
#pragma unroll
              for (int q = 0; q < 8; ++q) { kp[q] = k8[q] * ((a8[q] - 1.0f) * (q < 4 ? ka0[q] : ka1[q - 4]) + 1.0f); bs += r8[q] * kp[q] * (q < 4 ? rk0[q] : rk1[q - 4]); } }
            bs = row8_sum(bs);
            if (seg == 0) bonus[tq] = bs;
            float at[8], rt[8], bt[8], kt[8];
#pragma unroll
            for (int q = 0; q < 8; ++q) { const float eP = lp[q], eT = lt[q], eN = __builtin_amdgcn_rcpf(lt[q]);
                at[q] = -kk[q] * eP; rt[q] = r8[q] * eT; bt[q] = kk[q] * a8[q] * eN; kt[q] = kp[q] * eN; }
            u32x4 w;
            w.x = cvt_pk_bf16(at[0], at[1]); w.y = cvt_pk_bf16(at[2], at[3]); w.z = cvt_pk_bf16(at[4], at[5]); w.w = cvt_pk_bf16(at[6], at[7]); *(LAS u32x4*)(At + tq * LD + j0) = w;
            w.x = cvt_pk_bf16(rt[0], rt[1]); w.y = cvt_pk_bf16(rt[2], rt[3]); w.z = cvt_pk_bf16(rt[4], rt[5]); w.w = cvt_pk_bf16(rt[6], rt[7]); *(LAS u32x4*)(Rt + tq * LD + j0) = w;
            w.x = cvt_pk_bf16(bt[0], bt[1]); w.y = cvt_pk_bf16(bt[2], bt[3]); w.z = cvt_pk_bf16(bt[4], bt[5]); w.w = cvt_pk_bf16(bt[6], bt[7]); *(LAS u32x4*)(Bt + tq * LD + j0) = w;
            w.x = cvt_pk_bf16(kt[0], kt[1]); w.y = cvt_pk_bf16(kt[2], kt[3]); w.z = cvt_pk_bf16(kt[4], kt[5]); w.w = cvt_pk_bf16(kt[6], kt[7]); *(LAS u32x4*)(Kt + tq * LD + j0) = w;
        }
        if (RKP == 9 && rp_ == 0) __syncthreads(); }
        __syncthreads();
        for (int rp_ = 0; rp_ < (RKP == 1 ? 2 : 1); ++rp_) {
        { RK_IDS();
          { const u32x4 z = {0u, 0u, 0u, 0u}; for (int i = tidv_; i < SLOT / 16; i += NTHR) ((LAS u32x4*)Tm)[i] = z; }
          bf16x8 fb[2], fk[2], fa[2][2], frr[2][2];
#pragma unroll
          for (int ks = 0; ks < 2; ++ks) { const int kc = ks * 32 + fq * 8; fb[ks] = FRN(Bt, mt * 16 + fr, kc); fk[ks] = FRN(Kt, mt * 16 + fr, kc);
#pragma unroll
              for (int jn = 0; jn < 2; ++jn) { fa[jn][ks] = FRN(At, (nt0 + jn) * 16 + fr, kc); frr[jn][ks] = FRN(Rt, (nt0 + jn) * 16 + fr, kc); } }
          f32x4 c1[2][4];
#pragma unroll
          for (int jn = 0; jn < 2; ++jn) {
#pragma unroll
              for (int i = 0; i < 4; ++i) c1[jn][i] = (f32x4){0.f, 0.f, 0.f, 0.f};
#pragma unroll
              for (int ks = 0; ks < 2; ++ks) { c1[jn][0] = mma(fb[ks], fa[jn][ks], c1[jn][0]); c1[jn][1] = mma(fk[ks], fa[jn][ks], c1[jn][1]); c1[jn][2] = mma(fb[ks], frr[jn][ks], c1[jn][2]); c1[jn][3] = mma(fk[ks], frr[jn][ks], c1[jn][3]); } }
#pragma unroll
        for (int jn = 0; jn < 2; ++jn) { const int nt = nt0 + jn;
            f32x4 cbb = c1[jn][0], ckb = c1[jn][1], cbr = c1[jn][2], ckr = c1[jn][3];
            const int t = nt * 16 + fr;
#pragma unroll
            for (int r = 0; r < 4; ++r) { const int sidx = mt * 16 + fq * 4 + r;
                if (!(sidx < t)) { cbb[r] = 0.f; ckb[r] = 0.f; } if (!(sidx <= t)) { cbr[r] = 0.f; ckr[r] = 0.f; } }
            *(LAS f32x4*)(AabF + t * LD + mt * 16 + fq * 4) = cbb;
            storeT(Aab, mt, nt, fr, fq, cbb); storeT(Aak, mt, nt, fr, fq, ckb); storeT(Arb, mt, nt, fr, fq, cbr); storeT(Ark, mt, nt, fr, fq, ckr);
        } }
        if (RKP == 1 && rp_ == 0) __syncthreads(); }
        __syncthreads();
#define RK_P5A(MT_, NT_, CY_, CS_) do { _Pragma("unroll") for (int ks = 0; ks < 2; ++ks) { const int kc = ks * 32 + fq * 8; bf16x8 fkt, fvn, fvm; \
            FRT(fkt, Kt, ks * 32, 16 * (MT_)); FRT(fvn, Vm, ks * 32, 16 * (NT_)); FRT(fvm, Vm, ks * 32, 16 * (MT_)); \
            CS_ = mma(fkt, fvn, CS_); CY_ = mma(FRN(Sst, (MT_) * 16 + fr, kc), FRN(Rt, (NT_) * 16 + fr, kc), CY_); CY_ = mma(fvm, FRN(Ark, (NT_) * 16 + fr, kc), CY_); } } while (0)
        f32x4 cyp[2], csp[2];
        for (int rp_ = 0; rp_ < (RKP == 2 ? 2 : 1); ++rp_) {
        cyp[0] = (f32x4){0.f, 0.f, 0.f, 0.f}; cyp[1] = cyp[0]; csp[0] = cyp[0]; csp[1] = cyp[0];
        if (F.wave == 0) {
            RK_IDS();
            { const int d = lanev_ >> 4, c = lanev_ & 15;
              const LAS float* ab = AabF + (16 * d) * LD + 16 * d;
              float qa[16][16], x[16];
#define RK_LROWS(R0, R1) _Pragma("unroll") for (int r = (R0); r <= (R1); ++r) _Pragma("unroll") for (int pq = 0; pq < r; ++pq) qa[r][pq] = ab[r * LD + pq]
#define RK_SROWS(R0, R1) _Pragma("unroll") for (int r = (R0); r <= (R1); ++r) { float a = (r == c) ? 1.0f : 0.f, a1 = 0.f; \
                  _Pragma("unroll") for (int pq = 0; pq + 1 < r; ++pq) { if (pq & 1) a1 += qa[r][pq] * x[pq]; else a += qa[r][pq] * x[pq]; } \
                  a += a1; if (r > 0) a += qa[r][r - 1] * x[r - 1]; x[r] = a; }
              RK_LROWS(1, 6); RK_LROWS(7, 9); __builtin_amdgcn_sched_barrier(0);
              RK_SROWS(0, 6);
              RK_LROWS(10, 12); __builtin_amdgcn_sched_barrier(0);
              RK_SROWS(7, 9);
              RK_LROWS(13, 15); __builtin_amdgcn_sched_barrier(0);
              RK_SROWS(10, 12);
              RK_SROWS(13, 15);
#undef RK_LROWS
#undef RK_SROWS
#pragma unroll
              for (int r = 0; r < 16; ++r) Tm[(16 * d + r) * LD + 16 * d + c] = f2bf(x[r]); }
            const bf16x8 z8 = {0, 0, 0, 0, 0, 0, 0, 0};
            { bf16x8 a0 = FRN(Aab, 16 + fr, (fq & 1) * 8), a1 = FRN(Aab, 48 + fr, 32 + (fq & 1) * 8), bb0, bb1;
              bf16x8 c0 = FRN(Tm, 16 + fr, 16 + (fq & 1) * 8), c1 = FRN(Tm, 48 + fr, 48 + (fq & 1) * 8);
              FRT(bb0, Tm, 0, 0); FRT(bb1, Tm, 32, 32);
              if (fq >= 2) { a0 = z8; a1 = z8; c0 = z8; c1 = z8; }
              f32x4 e0 = {0.f, 0.f, 0.f, 0.f}, e1 = e0; e0 = mma(a0, bb0, e0); e1 = mma(a1, bb1, e1);
              storeT(EB, 0, 0, fr, fq, e0); storeT(EB, 0, 1, fr, fq, e1);
              bf16x8 g0 = FRN(EB, fr, (fq & 1) * 8), g1 = FRN(EB, 16 + fr, (fq & 1) * 8);
              if (fq >= 2) { g0 = z8; g1 = z8; }
              f32x4 h0 = {0.f, 0.f, 0.f, 0.f}, h1 = h0; h0 = mma(g0, c0, h0); h1 = mma(g1, c1, h1);
              storeT(Tm, 0, 1, fr, fq, h0); storeT(Tm, 2, 3, fr, fq, h1); }
            { bf16x8 bb[2], aA[2], tT[2], eE[2]; f32x4 e[4];
              FRT(bb[0], Tm, 0, 0); FRT(bb[1], Tm, 0, 16);
#pragma unroll
              for (int m2 = 0; m2 < 2; ++m2) { aA[m2] = FRN(Aab, 32 + m2 * 16 + fr, fq * 8); tT[m2] = FRN(Tm, 32 + m2 * 16 + fr, 32 + fq * 8); }
#pragma unroll
              for (int tl = 0; tl < 4; ++tl) { e[tl] = (f32x4){0.f, 0.f, 0.f, 0.f}; e[tl] = mma(aA[tl >> 1], bb[tl & 1], e[tl]); }
#pragma unroll
              for (int tl = 0; tl < 4; ++tl) storeT(EB, 2 + (tl >> 1), tl & 1, fr, fq, e[tl]);
#pragma unroll
              for (int n2 = 0; n2 < 2; ++n2) eE[n2] = FRN(EB, n2 * 16 + fr, 32 + fq * 8);
#pragma unroll
              for (int tl = 0; tl < 4; ++tl) { e[tl] = (f32x4){0.f, 0.f, 0.f, 0.f}; e[tl] = mma(eE[tl & 1], tT[tl >> 1], e[tl]); }
#pragma unroll
              for (int tl = 0; tl < 4; ++tl) storeT(Tm, tl & 1, 2 + (tl >> 1), fr, fq, e[tl]); }
        } else if (F.wave >= 4) {
            RK_IDS(); const int mtw = F.wave - 4;
            bf16x8 fak[2], fat[2];
#pragma unroll
            for (int ks = 0; ks < 2; ++ks) { fak[ks] = FRN(Aak, mtw * 16 + fr, ks * 32 + fq * 8); fat[ks] = FRN(At, mtw * 16 + fr, ks * 32 + fq * 8); }
#pragma unroll
            for (int np = 0; np < 2; ++np) {
                bf16x8 bv[2][2], bs[2][2]; f32x4 cwv[2];
#pragma unroll
                for (int j2 = 0; j2 < 2; ++j2)
#pragma unroll
                    for (int ks = 0; ks < 2; ++ks) { FRT(bv[j2][ks], Vm, ks * 32, 16 * (np * 2 + j2)); bs[j2][ks] = FRN(Sst, (np * 2 + j2) * 16 + fr, ks * 32 + fq * 8); }
#pragma unroll
                for (int j2 = 0; j2 < 2; ++j2) { cwv[j2] = (f32x4){0.f, 0.f, 0.f, 0.f};
#pragma unroll
                    for (int ks = 0; ks < 2; ++ks) { cwv[j2] = mma(fak[ks], bv[j2][ks], cwv[j2]); cwv[j2] = mma(fat[ks], bs[j2][ks], cwv[j2]); } }
#pragma unroll
                for (int j2 = 0; j2 < 2; ++j2) storeT(WT, mtw, np * 2 + j2, fr, fq, cwv[j2]); }
        }
        if (F.wave != 0) { RK_IDS();
            RK_P5A(mt, nt0, cyp[0], csp[0]); RK_P5A(mt, nt0 + 1, cyp[1], csp[1]);
            if (F.wave <= 2) { f32x4 hy = {0.f, 0.f, 0.f, 0.f}, hs = hy; const int ntw = F.wave - 1;
                RK_P5A(0, ntw, hy, hs);
                *(LAS f32x4*)(H0 + ((ntw * 2 + 0) * 64 + lanev_) * 4) = hy; *(LAS f32x4*)(H0 + ((ntw * 2 + 1) * 64 + lanev_) * 4) = hs; } }
        if (RKP == 2 && rp_ == 0) __syncthreads(); }
        __syncthreads();
        for (int rp_ = 0; rp_ < (RKP == 3 ? 2 : 1); ++rp_) {
        { RK_IDS();
          bf16x8 ft[2], fw[2][2]; f32x4 cu[2];
#pragma unroll
          for (int ks = 0; ks < 2; ++ks) { const int kc = ks * 32 + fq * 8; ft[ks] = FRN(Tm, mt * 16 + fr, kc); fw[0][ks] = FRN(WT, nt0 * 16 + fr, kc); fw[1][ks] = FRN(WT, (nt0 + 1) * 16 + fr, kc); }
#pragma unroll
          for (int jn = 0; jn < 2; ++jn) { cu[jn] = (f32x4){0.f, 0.f, 0.f, 0.f};
#pragma unroll
              for (int ks = 0; ks < 2; ++ks) cu[jn] = mma(ft[ks], fw[jn][ks], cu[jn]); }
#pragma unroll
          for (int jn = 0; jn < 2; ++jn) storeT(U0T, mt, nt0 + jn, fr, fq, cu[jn]); }
        if (RKP == 3 && rp_ == 0) __syncthreads(); }
        __syncthreads();
        for (int rp_ = 0; rp_ < (RKP == 5 ? 2 : 1); ++rp_) {
        { RK_IDS();
          bf16x8 fbt[2], fum[2], fun[2][2], frb[2][2]; f32x4 cy2[2], cs2[2];
#pragma unroll
          for (int ks = 0; ks < 2; ++ks) { const int kc = ks * 32 + fq * 8; FRT(fbt[ks], Bt, ks * 32, 16 * mt); fum[ks] = FRN(U0T, mt * 16 + fr, kc);
#pragma unroll
              for (int jn = 0; jn < 2; ++jn) { fun[jn][ks] = FRN(U0T, (nt0 + jn) * 16 + fr, kc); frb[jn][ks] = FRN(Arb, (nt0 + jn) * 16 + fr, kc); } }
#pragma unroll
          for (int jn = 0; jn < 2; ++jn) { cy2[jn] = cyp[jn]; cs2[jn] = csp[jn];
              if (F.wave == 0) { cy2[jn] = *(const LAS f32x4*)(H0 + ((jn * 2 + 0) * 64 + lanev_) * 4); cs2[jn] = *(const LAS f32x4*)(H0 + ((jn * 2 + 1) * 64 + lanev_) * 4); } }
#pragma unroll
          for (int jn = 0; jn < 2; ++jn)
#pragma unroll
              for (int ks = 0; ks < 2; ++ks) { cs2[jn] = mma(fbt[ks], fun[jn][ks], cs2[jn]);
                  cy2[jn] = mma(fum[ks], frb[jn][ks], cy2[jn]); }
#pragma unroll
        for (int jn = 0; jn < 2; ++jn) { const int nt = nt0 + jn;
            const f32x4 cy = cy2[jn], cs = cs2[jn];
            if (rp_ == 0) {
#pragma unroll
                for (int r = 0; r < 4; ++r) sn[jn][r] = (sn[jn][r] + cs[r]) * gL[mt * 16 + fq * 4 + r]; }
            *(LAS f32x4*)(Yf + (nt * 16 + fr) * LD + mt * 16 + fq * 4) = cy; } }
        if (RKP == 5 && rp_ == 0) __syncthreads(); }
        __syncthreads();
        for (int rp_ = 0; rp_ < (RKP == 6 ? 2 : 1); ++rp_) {
        {
            RK_IDS();
            storeT(Sst, mt, nt0, fr, fq, sn[0]); storeT(Sst, mt, nt0 + 1, fr, fq, sn[1]);
            float y[8]; { const f32x4 y0 = *(const LAS f32x4*)(Yf + tq * LD + j0), y1 = *(const LAS f32x4*)(Yf + tq * LD + j0 + 4);
                y[0] = y0.x; y[1] = y0.y; y[2] = y0.z; y[3] = y0.w; y[4] = y1.x; y[5] = y1.y; y[6] = y1.z; y[7] = y1.w; }
            float sm = 0.f;
#pragma unroll
            for (int q = 0; q < 8; ++q) sm += y[q];
            sm = row8_sum(sm); const float mean = sm * (1.0f / 64.0f);
            float vs = 0.f;
#pragma unroll
            for (int q = 0; q < 8; ++q) { y[q] -= mean; vs += y[q] * y[q]; }
            vs = row8_sum(vs); const float rstd = __builtin_amdgcn_rsqf(vs * (1.0f / 64.0f) + 64e-5f);
            const u32x4 gv = *(const LAS u32x4*)(GG + tq * LD + j0); const float bn = bonus[tq];
            float g8[8];
#pragma unroll
            for (int q = 0; q < 4; ++q) { g8[2 * q] = bf_lo(gv[q]); g8[2 * q + 1] = bf_hi(gv[q]); }
            float o[8];
#pragma unroll
            for (int q = 0; q < 8; ++q) o[q] = (y[q] * rstd * prm[320 + j0 + q] + prm[384 + j0 + q] + bn * v8[q]) * g8[q];
            u32x4 w; w.x = cvt_pk_bf16(o[0], o[1]); w.y = cvt_pk_bf16(o[2], o[3]); w.z = cvt_pk_bf16(o[4], o[5]); w.w = cvt_pk_bf16(o[6], o[7]);
            *(u32x4*)(mix + (size_t)(t0 + tq) * D + j0) = w;
        }
        if (RKP == 6 && rp_ == 0) __syncthreads(); }
    }
#undef RK_IDS
#undef RK_LOADS
#undef FRN
#undef FRT
}

__device__ __forceinline__ float softcap15(float z) { return 15.0f * ftanh(z * (1.0f / 15.0f)); }
constexpr int ML_NA = 20;
__device__ __forceinline__ void p4_mlstm_v2(Frame& F) {
    if (F.bid >= 256) return;
    constexpr int LD = 72, LDV = 136, LDN = 132;
    const bool second = F.bid >= 128; const int chain = F.bid & 127;
    const int b = chain >> 2, h = chain & 3;
    const bf16_t* proj = (const bf16_t*)(F.ws + WS_PROJ) + (size_t)b * SEQ * NPROJ;
    const float* gates = (const float*)(F.ws + WS_GATES) + (size_t)b * SEQ * 8;
    bf16_t* mix = (bf16_t*)(F.ws + WS_MIX) + (size_t)b * SEQ * D + 512 + h * 128;
    LAS unsigned char* L = F.lds;
    LAS bf16_t* Qs = (LAS bf16_t*)(L + 0);
    LAS bf16_t* Qb = (LAS bf16_t*)(L + 9216);
    LAS bf16_t* Ks = (LAS bf16_t*)(L + 18432);
    LAS bf16_t* Kw = (LAS bf16_t*)(L + 27648);
    LAS bf16_t* Vm = (LAS bf16_t*)(L + 36864);
    LAS bf16_t* Sc = (LAS bf16_t*)(L + 54272);
    LAS bf16_t* CT = (LAS bf16_t*)(L + 63488);
    LAS float* Num = (LAS float*)(L + 81920);
    LAS float* nvec = (LAS float*)(L + 115712) + 128;
    LAS float* cw = nvec + 128;
    LAS float* cb = cw + 512;
    LAS float* hnw = cb + 128;
    LAS float* dpv = hnw + 128;
    LAS float* gbuf = dpv + 64;
    for (int i = F.tid; i < 512; i += NTHR) { const int j = i >> 7, c = i & 127; const int col = c < 64 ? (h * 64 + c) : (256 + h * 64 + (c - 64)); cw[i] = F.in[I_CONVW][j * 512 + col]; }
    for (int i = F.tid; i < 128; i += NTHR) { const int col = i < 64 ? (h * 64 + i) : (256 + h * 64 + (i - 64)); cb[i] = F.in[I_CONVB][col]; hnw[i] = F.in[I_HNW][h * 128 + i]; }
    for (int i = F.tid; i < 128 * LD / 2; i += NTHR) ((LAS unsigned*)CT)[i] = 0u;
    if (F.tid < 128) nvec[F.tid] = 0.f;
    const float ib = F.in[I_IB][h], fb = F.in[I_FB][h];
    const int mtl = F.wave >> 1, nh = F.wave & 1;
    f32x4 Cacc[4]; f32x4 nacc = {0.f, 0.f, 0.f, 0.f};
#pragma unroll
    for (int j = 0; j < 4; ++j) Cacc[j] = (f32x4){0.f, 0.f, 0.f, 0.f};
#define ML_IDS() int tidv_ = F.tid; asm volatile("" : "+v"(tidv_)); const int lanev_ = tidv_ & 63; const int fr = lanev_ & 15, fq = lanev_ >> 4; const int tq = tidv_ >> 3, seg = tidv_ & 7; (void)fr; (void)fq; (void)tq; (void)seg
#define MFRN(M, ld, row, k) (*(const LAS bf16x8*)((M) + (row) * (ld) + (k)))
#define MFRT(dst, M, ld, k0, c0) do { const LAS bf16_t* p_ = (M) + ((k0) + 8 * fq + (fr >> 2)) * (ld) + (c0) + 4 * (fr & 3); \
        const s16x4 lo_ = __builtin_amdgcn_ds_read_tr16_b64_v4i16((LAS s16x4*)p_); const s16x4 hi_ = __builtin_amdgcn_ds_read_tr16_b64_v4i16((LAS s16x4*)(p_ + 4 * (ld))); \
        dst = __builtin_shufflevector(lo_, hi_, 0, 1, 2, 3, 4, 5, 6, 7); } while (0)
    u32x4 pf[12]; float pig = 0.f, pfg = 0.f;
#pragma unroll
    for (int i = 0; i < 12; ++i) pf[i] = (u32x4){0u, 0u, 0u, 0u};
#define ML_LOADS(T0N, FULL) do { ML_IDS(); const int t_ = (T0N) + tq; const u32x4 z_ = {0u, 0u, 0u, 0u}; const bool isq_ = seg < 4; \
        const int colc_ = isq_ ? (C_MQ + h * 64 + seg * 16) : (C_MK + h * 64 + (seg - 4) * 16); \
        _Pragma("unroll") for (int j_ = 0; j_ < 4; ++j_) { const int tt_ = t_ - 3 + j_; pf[2 * j_] = z_; pf[2 * j_ + 1] = z_; \
            if (tt_ >= 0 && ((FULL) || !isq_)) { const bf16_t* rp_ = proj + (size_t)tt_ * NPROJ + colc_; pf[2 * j_] = *(const u32x4*)rp_; pf[2 * j_ + 1] = *(const u32x4*)(rp_ + 8); } } \
        { const bf16_t* vp_ = proj + (size_t)t_ * NPROJ + C_MV + h * 128 + seg * 16; pf[8] = *(const u32x4*)vp_; pf[9] = *(const u32x4*)(vp_ + 8); } \
        if (FULL) { const bf16_t* op_ = proj + (size_t)t_ * NPROJ + C_MO + h * 128 + seg * 16; pf[10] = *(const u32x4*)op_; pf[11] = *(const u32x4*)(op_ + 8); } \
        if (F.wave == 0) { const float* gp_ = gates + (size_t)((T0N) + lanev_) * 8; pig = gp_[h]; pfg = gp_[4 + h]; } } while (0)
#define ML_GATES(P) do { ML_IDS(); const float liv = softcap15(pig + ib); \
        const float xf = softcap15(pfg + fb); const float lf = fminf(xf, 0.f) - __logf(1.0f + __expf(-fabsf(xf))); float bs = lf; \
        _Pragma("unroll") for (int o = 1; o < 64; o <<= 1) { const float u = __shfl_up(bs, o); if (lanev_ >= o) bs += u; } \
        gbuf[(P) * 128 + lanev_] = bs; gbuf[(P) * 128 + 64 + lanev_] = liv; } while (0)
    const int c_end = second ? 32 : ML_NA;
    { const bool full0 = !second; ML_LOADS(0, full0); }
    if (F.wave == 0) ML_GATES(0);
    __syncthreads();
    int nb = 0;
#pragma unroll 1
    for (int c = 0; c < c_end; ++c) {
        const int t0 = c * 64; const bool full = !second || c >= ML_NA;
        {
            ML_IDS();
            const LAS float* bcum = gbuf + (c & 1) * 128; const LAS float* lis = bcum + 64;
            const float bL = bcum[63], bt = bcum[tq], lit = lis[tq];
            const float eb = __expf(bt), kwf = __expf(bL - bt + lit);
            const bool isq = seg < 4; const int c0 = seg * 16;
            if (full || !isq) {
                float o[16];
#pragma unroll
                for (int q = 0; q < 16; ++q) o[q] = cb[c0 + q];
#pragma unroll
                for (int j = 0; j < 4; ++j) {
#pragma unroll
                    for (int hh = 0; hh < 2; ++hh) { const u32x4 p = pf[2 * j + hh];
#pragma unroll
                        for (int q = 0; q < 4; ++q) { o[hh * 8 + 2 * q] += cw[j * 128 + c0 + hh * 8 + 2 * q] * bf_lo(p[q]); o[hh * 8 + 2 * q + 1] += cw[j * 128 + c0 + hh * 8 + 2 * q + 1] * bf_hi(p[q]); } } }
                const float sc1 = isq ? 0.125f : 1.0f, sc2 = isq ? 0.125f * eb : kwf;
#pragma unroll
                for (int q = 0; q < 16; ++q) o[q] = fsilu(o[q]);
                LAS bf16_t* d1 = (isq ? Qs : Ks) + tq * LD + (c0 & 63); LAS bf16_t* d2 = (isq ? Qb : Kw) + tq * LD + (c0 & 63);
#pragma unroll
                for (int hh = 0; hh < 2; ++hh) { u32x4 w1, w2;
                    w1.x = cvt_pk_bf16(o[hh * 8 + 0] * sc1, o[hh * 8 + 1] * sc1); w1.y = cvt_pk_bf16(o[hh * 8 + 2] * sc1, o[hh * 8 + 3] * sc1); w1.z = cvt_pk_bf16(o[hh * 8 + 4] * sc1, o[hh * 8 + 5] * sc1); w1.w = cvt_pk_bf16(o[hh * 8 + 6] * sc1, o[hh * 8 + 7] * sc1);
                    w2.x = cvt_pk_bf16(o[hh * 8 + 0] * sc2, o[hh * 8 + 1] * sc2); w2.y = cvt_pk_bf16(o[hh * 8 + 2] * sc2, o[hh * 8 + 3] * sc2); w2.z = cvt_pk_bf16(o[hh * 8 + 4] * sc2, o[hh * 8 + 5] * sc2); w2.w = cvt_pk_bf16(o[hh * 8 + 6] * sc2, o[hh * 8 + 7] * sc2);
                    *(LAS u32x4*)(d1 + hh * 8) = w1; *(LAS u32x4*)(d2 + hh * 8) = w2; }
            }
            *(LAS u32x4*)(Vm + tq * LDV + seg * 16) = pf[8]; *(LAS u32x4*)(Vm + tq * LDV + seg * 16 + 8) = pf[9];
        }
        const u32x4 og0 = pf[10], og1 = pf[11];
        if (c + 1 < c_end) { const bool fulln = !second || (c + 1) >= ML_NA; ML_LOADS(t0 + 64, fulln); }
        __syncthreads();
        {
            ML_IDS();
            const LAS float* bcum = gbuf + (c & 1) * 128; const LAS float* lis = bcum + 64;
            const float eL = __expf(bcum[63]);
            bf16x8 ak[2], av[4][2];
            if (full) { const int tt = mtl, hh = nh;
                const int t = tt * 16 + fr; const float btv = bcum[t];
                f32x4 g4[4], dm[4];
                { bf16x8 fks[4][2], fqs[2];
#pragma unroll
                  for (int ks = 0; ks < 2; ++ks) fqs[ks] = MFRN(Qs, LD, tt * 16 + fr, ks * 32 + fq * 8);
#pragma unroll
                  for (int ms = 0; ms < 4; ++ms) if (ms <= tt) {
#pragma unroll
                      for (int ks = 0; ks < 2; ++ks) fks[ms][ks] = MFRN(Ks, LD, ms * 16 + fr, ks * 32 + fq * 8); }
#pragma unroll
                  for (int ms = 0; ms < 4; ++ms) { g4[ms] = (f32x4){0.f, 0.f, 0.f, 0.f}; dm[ms] = g4[ms];
                      if (ms <= tt) {
                          const f32x4 bc = *(const LAS f32x4*)(bcum + ms * 16 + fq * 4), li = *(const LAS f32x4*)(lis + ms * 16 + fq * 4);
#pragma unroll
                          for (int ks = 0; ks < 2; ++ks) g4[ms] = rk::mma(fks[ms][ks], fqs[ks], g4[ms]);
#pragma unroll
                          for (int r = 0; r < 4; ++r) dm[ms][r] = (ms * 16 + fq * 4 + r <= t) ? __expf(btv - bc[r] + li[r]) : 0.f; } } }
                f32x4 a4[4]; bf16x8 bq[2];
#pragma unroll
                for (int ks = 0; ks < 2; ++ks) bq[ks] = MFRN(Qb, LD, tt * 16 + fr, ks * 32 + fq * 8);
#pragma unroll
                for (int jn = 0; jn < 4; ++jn) { a4[jn] = (f32x4){0.f, 0.f, 0.f, 0.f};
#pragma unroll
                    for (int ks = 0; ks < 2; ++ks) a4[jn] = rk::mma(MFRN(CT, LD, (hh * 4 + jn) * 16 + fr, ks * 32 + fq * 8), bq[ks], a4[jn]); }
                if (hh == 0) {
                    f32x4 dd = {0.f, 0.f, 0.f, 0.f};
#pragma unroll
                    for (int ks = 0; ks < 2; ++ks) { const f32x4 n0 = *(const LAS f32x4*)(nvec + nb * 64 + ks * 32 + fq * 8), n1 = *(const LAS f32x4*)(nvec + nb * 64 + ks * 32 + fq * 8 + 4);
                        u32x4 hi = {cvt_pk_bf16(n0[0], n0[1]), cvt_pk_bf16(n0[2], n0[3]), cvt_pk_bf16(n1[0], n1[1]), cvt_pk_bf16(n1[2], n1[3])};
                        u32x4 lo = {cvt_pk_bf16(n0[0] - bf_lo(hi.x), n0[1] - bf_hi(hi.x)), cvt_pk_bf16(n0[2] - bf_lo(hi.y), n0[3] - bf_hi(hi.y)), cvt_pk_bf16(n1[0] - bf_lo(hi.z), n1[1] - bf_hi(hi.z)), cvt_pk_bf16(n1[2] - bf_lo(hi.w), n1[3] - bf_hi(hi.w))};
                        const u32x4 z = {0u, 0u, 0u, 0u}; const u32x4 an = fr == 0 ? hi : fr == 1 ? lo : z;
                        dd = rk::mma(__builtin_bit_cast(bf16x8, an), bq[ks], dd); }
                    if (fq == 0) dpv[tt * 16 + fr] = dd[0] + dd[1]; }
#pragma unroll
                for (int ks = 0; ks < 2; ++ks) { MFRT(ak[ks], Kw, LD, ks * 32, 16 * mtl);
#pragma unroll
                    for (int jn = 0; jn < 4; ++jn) MFRT(av[jn][ks], Vm, LDV, ks * 32, 16 * (hh * 4 + jn)); }
#pragma unroll
                for (int ms = 0; ms < 4; ++ms) { const f32x4 g = g4[ms] * dm[ms];
                    u32x2 w; w.x = cvt_pk_bf16(g[0], g[1]); w.y = cvt_pk_bf16(g[2], g[3]); *(LAS u32x2*)(Sc + t * LD + ms * 16 + fq * 4) = w; }
                bf16x8 bs[2];
#pragma unroll
                for (int ks = 0; ks < 2; ++ks) bs[ks] = MFRN(Sc, LD, tt * 16 + fr, ks * 32 + fq * 8);
#pragma unroll
                for (int jn = 0; jn < 4; ++jn)
#pragma unroll
                    for (int ks = 0; ks < 2; ++ks) a4[jn] = rk::mma(av[jn][ks], bs[ks], a4[jn]);
#pragma unroll
                for (int jn = 0; jn < 4; ++jn) *(LAS f32x4*)(Num + (tt * 16 + fr) * LDN + (hh * 4 + jn) * 16 + fq * 4) = a4[jn];
            } else {
#pragma unroll
                for (int ks = 0; ks < 2; ++ks) { MFRT(ak[ks], Kw, LD, ks * 32, 16 * mtl);
#pragma unroll
                    for (int jn = 0; jn < 4; ++jn) MFRT(av[jn][ks], Vm, LDV, ks * 32, 16 * (nh * 4 + jn)); }
            }
#pragma unroll
            for (int jn = 0; jn < 4; ++jn) {
                Cacc[jn] = Cacc[jn] * eL;
#pragma unroll
                for (int ks = 0; ks < 2; ++ks) Cacc[jn] = rk::mma(ak[ks], av[jn][ks], Cacc[jn]); }
            if (nh == 0) {
                bf16x8 ones;
#pragma unroll
                for (int e = 0; e < 8; ++e) ones[e] = (fr == 0) ? (short)0x3F80 : (short)0;
                nacc = nacc * eL;
#pragma unroll
                for (int ks = 0; ks < 2; ++ks) nacc = rk::mma(ak[ks], ones, nacc);
                if (fr == 0) {
#pragma unroll
                    for (int r = 0; r < 4; ++r) nvec[(nb ^ 1) * 64 + mtl * 16 + fq * 4 + r] = nacc[r]; } }
        }
        if (F.wave == 0 && c + 1 < c_end) ML_GATES((c + 1) & 1);
        __syncthreads();
        {
            ML_IDS();
#pragma unroll
            for (int jn = 0; jn < 4; ++jn) { const int ntl = nh * 4 + jn; u32x2 w; w.x = cvt_pk_bf16(Cacc[jn][0], Cacc[jn][1]); w.y = cvt_pk_bf16(Cacc[jn][2], Cacc[jn][3]);
                *(LAS u32x2*)(CT + (ntl * 16 + fr) * LD + mtl * 16 + fq * 4) = w; }
            if (full) {
                const int dv0 = seg * 16;
                float ds;
                { const u32x4 sv = *(const LAS u32x4*)(Sc + tq * LD + seg * 8);
                  ds = (bf_lo(sv.x) + bf_hi(sv.x)) + (bf_lo(sv.y) + bf_hi(sv.y)) + (bf_lo(sv.z) + bf_hi(sv.z)) + (bf_lo(sv.w) + bf_hi(sv.w)); }
                const float den = row8_sum(ds) + dpv[tq];
                const float inv = 1.0f / fmaxf(fabsf(den), 1.0f);
                float hv[16]; float ss = 0.f;
#pragma unroll
                for (int q = 0; q < 4; ++q) { const f32x4 nv = *(const LAS f32x4*)(Num + tq * LDN + dv0 + 4 * q);
                    hv[4 * q] = nv.x * inv; hv[4 * q + 1] = nv.y * inv; hv[4 * q + 2] = nv.z * inv; hv[4 * q + 3] = nv.w * inv;
                    ss += (hv[4 * q] * hv[4 * q] + hv[4 * q + 1] * hv[4 * q + 1]) + (hv[4 * q + 2] * hv[4 * q + 2] + hv[4 * q + 3] * hv[4 * q + 3]); }
                ss = row8_sum(ss);
                const float rms = __builtin_amdgcn_rsqf(ss * (1.0f / 128.0f) + 1e-6f);
                float ov[16];
#pragma unroll
                for (int q = 0; q < 4; ++q) { ov[2 * q] = bf_lo(og0[q]); ov[2 * q + 1] = bf_hi(og0[q]); ov[8 + 2 * q] = bf_lo(og1[q]); ov[8 + 2 * q + 1] = bf_hi(og1[q]); }
                unsigned pk[8];
#pragma unroll
                for (int q = 0; q < 8; ++q) { const float a = hv[2 * q] * rms * hnw[dv0 + 2 * q] * fsigmoid(ov[2 * q]), cc = hv[2 * q + 1] * rms * hnw[dv0 + 2 * q + 1] * fsigmoid(ov[2 * q + 1]); pk[q] = cvt_pk_bf16(a, cc); }
                u32x4* dst = (u32x4*)(mix + (size_t)(t0 + tq) * D + dv0);
                dst[0] = (u32x4){pk[0], pk[1], pk[2], pk[3]}; dst[1] = (u32x4){pk[4], pk[5], pk[6], pk[7]};
            }
        }
        nb ^= 1;
    }
#undef ML_GATES
#undef ML_IDS
#undef ML_LOADS
#undef MFRN
#undef MFRT
}

template <bool COUNT> __device__ __forceinline__ void p6_norm2_route(Frame& F) {
    constexpr int LDW = 1032;
    const bf16_t* x1 = (const bf16_t*)(F.ws + WS_X1); const float* nw = F.in[I_FFNNW];
    const float* mod = (const float*)(F.ws + WS_MOD);
    bf16_t* H2 = (bf16_t*)(F.ws + WS_H);
    int* route = (int*)(F.ws + WS_ROUTE); float* routew = (float*)(F.ws + WS_ROUTEW);
    unsigned* cnt = (unsigned*)(F.ws + WS_CTL) + CW_CNT;
    LAS bf16_t* Wr = (LAS bf16_t*)F.lds;
    LAS float* g2 = (LAS float*)(F.lds + 99072);
    LAS float* shv = g2 + 1024;
    LAS float* bl = shv + 1024;
    LAS unsigned* lcnt = (LAS unsigned*)(bl + 48);
    LAS unsigned* lbase = lcnt + 32;
    LAS float* scr = (LAS float*)(lbase + 32) + F.wave * 768;
    LAS int* rec = (LAS int*)((LAS float*)(lbase + 32) + 8 * 768) + F.wave * 192;
    const int b = F.bid >> 3;
    for (int i = F.tid; i < 48 * 1024; i += NTHR) { const int n = i >> 10, k = i & 1023; const float w = n < 4 ? F.in[I_WGRP][k * 4 + n] : (n < 36 ? F.in[I_WRT][k * 32 + (n - 4)] : 0.f); Wr[n * LDW + k] = f2bf(w); }
    for (int k = F.tid; k < 1024; k += NTHR) { g2[k] = nw[k] * (1.0f + mod[b * 6144 + 4096 + k]); shv[k] = mod[b * 6144 + 3072 + k]; }
    if (F.tid < 48) bl[F.tid] = F.tid < 4 ? F.in[I_BGRP][F.tid] : (F.tid < 36 ? F.in[I_BRT][F.tid - 4] : 0.f);
    if (F.tid < 32) lcnt[F.tid] = 0u;
    __syncthreads();
    const int fr = F.lane & 15, fq = F.lane >> 4;
#pragma unroll 1
    for (int gs = 0; gs < 2; ++gs) {
        const int grp = (F.bid & 7) * 16 + F.wave * 2 + gs;
        const size_t row = (size_t)b * SEQ + grp * 16 + fr;
        const bf16_t* xr = x1 + row * D + fq * 8;
        float ss = 0.f;
#pragma unroll 8
        for (int ks = 0; ks < 32; ++ks) { const u32x4 xv = *(const u32x4*)(xr + ks * 32);
#pragma unroll
            for (int q = 0; q < 4; ++q) { const float lo = bf_lo(xv[q]), hi = bf_hi(xv[q]); ss += lo * lo + hi * hi; } }
        ss += __shfl_xor(ss, 16); ss += __shfl_xor(ss, 32);
        const float rstd = __builtin_amdgcn_rsqf(ss * (1.0f / D) + 1e-6f);
        f32x4 acc[3];
#pragma unroll
        for (int nt = 0; nt < 3; ++nt) acc[nt] = (f32x4){0.f, 0.f, 0.f, 0.f};
        bf16_t* hr = H2 + row * D + fq * 8;
#pragma unroll 4
        for (int ks = 0; ks < 32; ++ks) {
            const int k0 = ks * 32 + fq * 8;
            const f32x4 ga = *(const LAS f32x4*)(g2 + k0), gb = *(const LAS f32x4*)(g2 + k0 + 4), sa = *(const LAS f32x4*)(shv + k0), sb = *(const LAS f32x4*)(shv + k0 + 4);
            const u32x4 xv = *(const u32x4*)(xr + ks * 32);
            u32x4 hw;
            hw.x = cvt_pk_bf16(bf_lo(xv.x) * rstd * ga.x + sa.x, bf_hi(xv.x) * rstd * ga.y + sa.y);
            hw.y = cvt_pk_bf16(bf_lo(xv.y) * rstd * ga.z + sa.z, bf_hi(xv.y) * rstd * ga.w + sa.w);
            hw.z = cvt_pk_bf16(bf_lo(xv.z) * rstd * gb.x + sb.x, bf_hi(xv.z) * rstd * gb.y + sb.y);
            hw.w = cvt_pk_bf16(bf_lo(xv.w) * rstd * gb.z + sb.z, bf_hi(xv.w) * rstd * gb.w + sb.w);
            *(u32x4*)(hr + ks * 32) = hw;
            const bf16x8 af = __builtin_bit_cast(bf16x8, hw);
#pragma unroll
            for (int nt = 0; nt < 3; ++nt) acc[nt] = __builtin_amdgcn_mfma_f32_16x16x32_bf16(af, *(const LAS bf16x8*)(Wr + (nt * 16 + fr) * LDW + k0), acc[nt], 0, 0, 0);
        }
#pragma unroll
        for (int nt = 0; nt < 3; ++nt) { const float bv = bl[nt * 16 + fr];
#pragma unroll
            for (int r = 0; r < 4; ++r) scr[(fq * 4 + r) * 48 + nt * 16 + fr] = acc[nt][r] + bv; }
        if (F.lane < 16) {
            const LAS float* lg = scr + F.lane * 48;
            const float g0 = lg[0], g1 = lg[1], gg2 = lg[2], g3 = lg[3];
            int gi = 0; float gm = g0; if (g1 > gm) { gm = g1; gi = 1; } if (gg2 > gm) { gm = gg2; gi = 2; } if (g3 > gm) { gm = g3; gi = 3; }
            const float gwgt = 1.0f / (__expf(g0 - gm) + __expf(g1 - gm) + __expf(gg2 - gm) + __expf(g3 - gm));
            float ev[8];
#pragma unroll
            for (int q = 0; q < 8; ++q) ev[q] = lg[4 + gi * 8 + q];
            int i0 = 0; float v0 = ev[0];
#pragma unroll
            for (int q = 1; q < 8; ++q) if (ev[q] > v0) { v0 = ev[q]; i0 = q; }
            int i1 = -1; float v1 = -3.0e38f;
#pragma unroll
            for (int q = 0; q < 8; ++q) if (q != i0 && ev[q] > v1) { v1 = ev[q]; i1 = q; }
            const float tw0 = 1.0f / (1.0f + __expf(v1 - v0)), tw1 = 1.0f - tw0;
            const int e0 = gi * 8 + i0, e1 = gi * 8 + i1;
            unsigned r0 = 0u, r1 = 0u;
            if (COUNT) { r0 = __hip_atomic_fetch_add(lcnt + e0, 1u, __ATOMIC_RELAXED, __HIP_MEMORY_SCOPE_WORKGROUP); r1 = __hip_atomic_fetch_add(lcnt + e1, 1u, __ATOMIC_RELAXED, __HIP_MEMORY_SCOPE_WORKGROUP); }
            LAS int* rc = rec + (gs * 16 + F.lane) * 6;
            rc[0] = e0; rc[1] = e1; rc[2] = (int)r0; rc[3] = (int)r1; rc[4] = __float_as_int(gwgt * tw0); rc[5] = __float_as_int(gwgt * tw1);
        }
    }
    __syncthreads();
    if (COUNT && F.tid < 32) lbase[F.tid] = __hip_atomic_fetch_add(cnt + 64 * F.tid, lcnt[F.tid], __ATOMIC_RELAXED, __HIP_MEMORY_SCOPE_AGENT);
    __syncthreads();
    if (COUNT && F.lane < 32) { const LAS int* rc = rec + F.lane * 6; const int grp = (F.bid & 7) * 16 + F.wave * 2 + (F.lane >> 4); const size_t m = (size_t)b * SEQ + grp * 16 + (F.lane & 15);
        *(int4*)(route + m * 4) = make_int4(rc[0], rc[1], rc[2] + (int)lbase[rc[0]], rc[3] + (int)lbase[rc[1]]);
        *(float2*)(routew + m * 2) = make_float2(__int_as_float(rc[4]), __int_as_float(rc[5])); }
}

__device__ __forceinline__ int moe_table(Frame& F, LAS int* tile_e, LAS int* start) {
    unsigned* cnt = (unsigned*)(F.ws + WS_CTL) + CW_CNT;
    if (F.wave == 0) {
        const int e = F.lane; int c = 0; if (e < NE) c = (int)__hip_atomic_load(cnt + 64 * e, __ATOMIC_RELAXED, __HIP_MEMORY_SCOPE_AGENT);
        const int nt = (c + 255) >> 8; int inc = nt;
#pragma unroll
        for (int o = 1; o < 64; o <<= 1) { const int u = __shfl_up(inc, o); if (F.lane >= o) inc += u; }
        const int st = inc - nt;
        if (e < NE) { start[e] = st; for (int q = 0; q < nt; ++q) if (st + q < MAXTILES) tile_e[st + q] = e; }
        if (e == NE - 1) start[NE] = inc < MAXTILES ? inc : MAXTILES; }
    __syncthreads();
    return start[NE];
}
__device__ __forceinline__ void p7_scatter(Frame& F) {
    LAS int* tile_e = (LAS int*)(F.lds); LAS int* start = tile_e + MAXTILES;
    (void)moe_table(F, tile_e, start);
    const int* route = (const int*)(F.ws + WS_ROUTE); const float* routew = (const float*)(F.ws + WS_ROUTEW);
    unsigned* cnt = (unsigned*)(F.ws + WS_CTL) + CW_CNT;
    u32x2* slot = (u32x2*)(F.ws + WS_SLOT);
    for (int m = F.bid * NTHR + F.tid; m < T; m += F.G * NTHR) {
        const int4 r = *(const int4*)(route + (size_t)m * 4); const float2 w = *(const float2*)(routew + (size_t)m * 2);
        const int s0 = start[r.x] * 256 + r.z, s1 = start[r.y] * 256 + r.w;
        slot[s0] = (u32x2){(unsigned)m, __float_as_uint(w.x)};
        slot[s1] = (u32x2){(unsigned)m | 0x40000000u, __float_as_uint(w.y)};
    }
    if (F.bid < NE) { const int e = F.bid; const int c = (int)__hip_atomic_load(cnt + 64 * e, __ATOMIC_RELAXED, __HIP_MEMORY_SCOPE_AGENT); const int nt = (c + 255) >> 8;
        for (int i = c + F.tid; i < nt * 256; i += NTHR) slot[start[e] * 256 + i] = (u32x2){0xffffffffu, 0u}; }
}

__device__ __forceinline__ void p10_final(Frame& F) {
    LAS int* tile_e = (LAS int*)(F.lds); LAS int* start = tile_e + MAXTILES;
    (void)moe_table(F, tile_e, start);
    const float* mod = (const float*)(F.ws + WS_MOD);
    const bf16_t* moes = (const bf16_t*)(F.ws + WS_MOE);
    const int* route = (const int*)(F.ws + WS_ROUTE); const float* routew = (const float*)(F.ws + WS_ROUTEW);
    const float* fw = F.in[I_FINW];
    f32x4 fwv[4];
#pragma unroll
    for (int j = 0; j < 4; ++j) fwv[j] = *(const f32x4*)(fw + 4 * F.lane + 256 * j);
    const int gw = F.bid * NWAVES + F.wave; const int b = gw >> 6; const int r0 = b * SEQ + (gw & 63);
    const int nrows = gw < NB * 64 ? 32 : 0;
    f32x4 gfv[4];
#pragma unroll
    for (int j = 0; j < 4; ++j) gfv[j] = *(const f32x4*)(mod + (b & 31) * 6144 + 5120 + 4 * F.lane + 256 * j);
    int ls0 = 0, ls1 = 0; float lw0 = 0.f, lw1 = 0.f;
    if (F.lane < nrows) { const int m = r0 + 64 * F.lane;
        const int4 rt = *(const int4*)(route + (size_t)m * 4); const float2 rw = *(const float2*)(routew + (size_t)m * 2);
        ls0 = start[rt.x] * 256 + rt.z; ls1 = start[rt.y] * 256 + rt.w; lw0 = rw.x; lw1 = rw.y; }
    const bf16_t* x1 = (const bf16_t*)(F.ws + WS_X1);
    u32x2 xv[4]; u32x2 ma[4], mc[4];
#define P10_LOAD(I) do { const int m_ = r0 + 64 * (I); \
        const size_t s0_ = (size_t)__builtin_amdgcn_readlane(ls0, (I)), s1_ = (size_t)__builtin_amdgcn_readlane(ls1, (I)); \
        const u32x2* xr_ = (const u32x2*)(x1 + (size_t)m_ * D + 4 * F.lane); const u32x2* m0_ = (const u32x2*)(moes + s0_ * D + 4 * F.lane); const u32x2* m1_ = (const u32x2*)(moes + s1_ * D + 4 * F.lane); \
        _Pragma("unroll") for (int j = 0; j < 4; ++j) { xv[j] = xr_[64 * j]; ma[j] = m0_[64 * j]; mc[j] = m1_[64 * j]; } } while (0)
    if (nrows > 0) P10_LOAD(0);
    for (int i = 0; i < nrows; ++i) {
        const int m = r0 + 64 * i;
        const float w0 = __builtin_bit_cast(float, __builtin_amdgcn_readlane(__builtin_bit_cast(int, lw0), i)), w1 = __builtin_bit_cast(float, __builtin_amdgcn_readlane(__builtin_bit_cast(int, lw1), i));
        f32x4 v[4]; float ss = 0.f;
#pragma unroll
        for (int j = 0; j < 4; ++j) { const u32x2 a = ma[j], c = mc[j];
            const f32x4 y = {bf_lo(a.x) * w0 + bf_lo(c.x) * w1, bf_hi(a.x) * w0 + bf_hi(c.x) * w1, bf_lo(a.y) * w0 + bf_lo(c.y) * w1, bf_hi(a.y) * w0 + bf_hi(c.y) * w1};
            const f32x4 xf = {bf_lo(xv[j].x), bf_hi(xv[j].x), bf_lo(xv[j].y), bf_hi(xv[j].y)};
            v[j] = xf + gfv[j] * y; ss += (v[j].x * v[j].x + v[j].y * v[j].y) + (v[j].z * v[j].z + v[j].w * v[j].w); }
        if (i + 1 < nrows) P10_LOAD(i + 1);
        ss = wave_sum(ss);
        const float rstd = __builtin_amdgcn_rsqf(ss * (1.0f / D) + 1e-6f);
        float* xo = F.out + (size_t)m * D + 4 * F.lane;
#pragma unroll
        for (int j = 0; j < 4; ++j) *(f32x4*)(xo + 256 * j) = (v[j] * rstd) * fwv[j];
    }
#undef P10_LOAD
}

constexpr int NPHASE = 11;
__global__ void __launch_bounds__(NTHR, 2) mk_fwd(Args args) {
    extern __shared__ __attribute__((aligned(16))) unsigned char lds_raw[];
    Frame F;
    F.lds = (LAS unsigned char*)lds_raw; F.in = args.in; F.out = args.out; F.ws = args.ws;
    F.tid = threadIdx.x; F.lane = F.tid & 63; F.wave = __builtin_amdgcn_readfirstlane(F.tid >> 6); F.bid = blockIdx.x; F.G = gridDim.x;
    volatile LAS unsigned* MISC = (volatile LAS unsigned*)(F.lds + MISC_OFF);
    if (F.tid < 64) MISC[F.tid] = 0u;
    __syncthreads();
    const int lo = args.ph_lo, hi = args.ph_hi;
    XcdBarrier bar; bar.bar = (unsigned*)(args.ws + WS_CTL) + CW_BAR; bar.x = 0; bar.st = nullptr;
    if (hi - lo > 1) bar = xcd_barrier_post((unsigned*)(args.ws + WS_CTL) + CW_BAR, MISC + 8);
#define IN(k) (lo <= (k) && (k) < hi)
#define SEAM(k) do { if (IN(k) && IN((k) + 1)) xcd_barrier(bar); } while (0)
#define REPS(k) for (int rep = 0; rep < ((MK_DUP == (k)) ? 2 : 1); ++rep)
    if (IN(0)) { REPS(0) { p0_prologue(F); __syncthreads(); } } SEAM(0);
    if (IN(1)) { REPS(1) { p1_norm1(F); __syncthreads(); } } SEAM(1);
#define GEMM_P2() do { DenseOrder<1024> S; S.init(F.ws + WS_H, F.ws + WS_WIN, T, NPROJ, F.G, F.bid, 4); EpiProj E{(bf16_t*)(F.ws + WS_PROJ)}; pg8::gemm_phase<1024, EpiProj, DenseOrder<1024>>(F.lds, S, E); } while (0)
    if (IN(2)) { GEMM_P2(); if (MK_DUP == 2) { __syncthreads(); GEMM_P2(); } } SEAM(2);
    if (IN(3)) { p3a_lin(F); REPS(4) { p4_mlstm_v2(F); __syncthreads(); } } SEAM(3);
    if (IN(4)) { REPS(3) { p3_rwkv_chunked(F); __syncthreads(); } } SEAM(4);
#define GEMM_P5() do { DenseOrder<1024> S; S.init(F.ws + WS_MIX, F.ws + WS_WOUT, T, D, F.G, F.bid); EpiOut E{F.in[I_X], (const float*)(F.ws + WS_MOD), (bf16_t*)(F.ws + WS_X1)}; pg8::gemm_phase<1024, EpiOut, DenseOrder<1024>>(F.lds, S, E); } while (0)
    if (IN(5)) { GEMM_P5(); if (MK_DUP == 5) { __syncthreads(); GEMM_P5(); } } SEAM(5);
    if (IN(6)) { if (MK_DUP == 6) { p6_norm2_route<false>(F); __syncthreads(); } p6_norm2_route<true>(F); } SEAM(6);
    if (IN(7)) { p7_scatter(F); } SEAM(7);
#define GEMM_P8() do { LAS int* tile_e = (LAS int*)(F.lds + pg8::STAGE_BYTES); LAS int* start = tile_e + MAXTILES; const int ntiles = moe_table(F, tile_e, start); \
        GateUpOrder S; S.A = (const char*)(F.ws + WS_H); S.W1 = (const char*)(F.ws + WS_W1); S.slot = (const u32x2*)(F.ws + WS_SLOT); S.tab = MoeTab{tile_e, ntiles}; S.nwg = ntiles * 2; S.G = F.G; S.c = F.bid; \
        EpiGateUp E{(bf16_t*)(F.ws + WS_HACT)}; pg8::gemm_phase<1024, EpiGateUp, GateUpOrder>(F.lds, S, E); __syncthreads(); } while (0)
#define GEMM_P9() do { LAS int* tile_e = (LAS int*)(F.lds + pg8::STAGE_BYTES); LAS int* start = tile_e + MAXTILES; const int ntiles = moe_table(F, tile_e, start); \
        DownOrder S; S.A = (const char*)(F.ws + WS_HACT); S.W2 = (const char*)(F.ws + WS_W2); S.tab = MoeTab{tile_e, ntiles}; S.nwg = ntiles * 4; S.G = F.G; S.c = F.bid; \
        EpiDown E{(bf16_t*)(F.ws + WS_MOE)}; pg8::gemm_phase<256, EpiDown, DownOrder>(F.lds, S, E); __syncthreads(); } while (0)
    if (IN(8)) { GEMM_P8(); if (MK_DUP == 8) GEMM_P8(); } SEAM(8);
    if (IN(9)) { GEMM_P9(); if (MK_DUP == 9) GEMM_P9(); } SEAM(9);
    if (IN(10)) { p10_final(F); }
#undef REPS
#undef IN
#undef SEAM
}

extern "C" void kernel_launch(void* const* d_in, const int* in_sizes, int n_in, void* d_out, int out_size, void* d_ws, size_t ws_size, hipStream_t stream) {
    static int grid = 0;
    if (grid == 0) {
        if (n_in != 32 || in_sizes[0] != T * D || out_size != T * D || ws_size < WS_END) { fprintf(stderr, "kernel_launch: unexpected shapes (n_in %d, in0 %d, out %d, ws %zu); nothing launched\n", n_in, n_in > 0 ? in_sizes[0] : -1, out_size, ws_size); grid = -1; return; }
        int dev = 0, cus = 0, per_cu = 0;
        if (hipGetDevice(&dev) != hipSuccess || hipDeviceGetAttribute(&cus, hipDeviceAttributeMultiprocessorCount, dev) != hipSuccess) { fprintf(stderr, "kernel_launch: device query failed\n"); grid = -1; return; }
        if (hipFuncSetAttribute((const void*)mk_fwd, hipFuncAttributeMaxDynamicSharedMemorySize, LDS_BYTES) != hipSuccess) { fprintf(stderr, "kernel_launch: hipFuncSetAttribute failed\n"); grid = -1; return; }
        if (hipOccupancyMaxActiveBlocksPerMultiprocessor(&per_cu, (const void*)mk_fwd, NTHR, LDS_BYTES) != hipSuccess || per_cu < 1) fprintf(stderr, "kernel_launch: occupancy query reports %d\n", per_cu);
        (void)hipGetLastError();
        grid = cus < 256 ? cus : 256;
        if (grid != 256) fprintf(stderr, "kernel_launch: %d CUs: this kernel is written for 256\n", cus);
    }
    if (grid < 0) return;
    (void)hipMemsetAsync((char*)d_ws + WS_CTL, 0, CTL_ZERO_BYTES, stream);
    Args a{};
    for (int i = 0; i < 32; ++i) a.in[i] = (const float*)d_in[i];
    a.out = (float*)d_out; a.ws = (unsigned char*)d_ws;
#if MK_ONE_LAUNCH
    a.ph_lo = 0; a.ph_hi = NPHASE;
    hipLaunchKernelGGL(mk_fwd, dim3(grid), dim3(NTHR), LDS_BYTES, stream, a);
#else
    for (int p = 0; p < NPHASE; ++p) { a.ph_lo = p; a.ph_hi = p + 1; hipLaunchKernelGGL(mk_fwd, dim3(grid), dim3(NTHR), LDS_BYTES, stream, a); }
#endif
}
```

```cpp
#include <hip/hip_runtime.h>
#include <cstdio>
#include <cstdint>

#ifndef MK_ONE_LAUNCH
#define MK_ONE_LAUNCH 1
#endif

#define RKP (MK_DUP - 30)
#ifndef MK_DUP
#define MK_DUP -1
#endif
#define LAS __attribute__((address_space(3)))
#define GAS __attribute__((address_space(1)))
typedef unsigned short bf16_t;
typedef short bf16x8 __attribute__((ext_vector_type(8)));
typedef float f32x4 __attribute__((ext_vector_type(4)));
typedef float f32x2 __attribute__((ext_vector_type(2)));
typedef unsigned u32x4 __attribute__((ext_vector_type(4)));
typedef unsigned u32x2 __attribute__((ext_vector_type(2)));
typedef short s16x4 __attribute__((ext_vector_type(4)));

constexpr int D = 1024, NB = 32, SEQ = 2048, T = NB * SEQ;
constexpr int IN_COLS = 3336, NPROJ = 3328;
constexpr int C_R = 0, C_K = 512, C_V = 1024, C_WD = 1536, C_AD = 1600, C_GD = 1664, C_MQ = 1792, C_MK = 2048, C_MV = 2304, C_MO = 2816;
constexpr int NE = 32, DE = 256;
constexpr int MAXTILES = 544;
constexpr int NTHR = 512, NWAVES = 8;

constexpr size_t MiB = 1u << 20;
constexpr size_t WS_CTL = 0, CTL_ZERO_BYTES = 64 * 1024;
constexpr size_t WS_MOD = 1 * MiB;
constexpr size_t WS_LORA = 2 * MiB;
constexpr size_t WS_GW = 2 * MiB + 512 * 1024;
constexpr size_t WS_ROUTE = 3 * MiB;
constexpr size_t WS_ROUTEW = 4 * MiB + 512 * 1024;
constexpr size_t WS_SLOT = 5 * MiB;
constexpr size_t WS_GATES = 7 * MiB;
constexpr size_t WS_WIN = 10 * MiB;
constexpr size_t WS_WOUT = 17 * MiB;
constexpr size_t WS_W1 = 20 * MiB;
constexpr size_t WS_W2 = 52 * MiB;
constexpr size_t WS_H = 72 * MiB;
constexpr size_t WS_MIX = 200 * MiB;
constexpr size_t WS_PROJ = 328 * MiB;
constexpr size_t WS_HACT = 328 * MiB;
constexpr size_t WS_MOE = 400 * MiB;
constexpr size_t WS_SLOTE = 680 * MiB;
constexpr size_t WS_X1 = 744 * MiB;
constexpr size_t WS_END = 872 * MiB;
constexpr int CW_BAR = 1024;
constexpr int CW_CNT = 8192;

constexpr int LDS_BYTES = 159744;
constexpr int MISC_OFF = 151552;

typedef __bf16 bf16v2 __attribute__((ext_vector_type(2)));
__device__ __forceinline__ unsigned cvt_pk_bf16(float lo, float hi) { const f32x2 f = {lo, hi}; const bf16v2 v = __builtin_convertvector(f, bf16v2); return __builtin_bit_cast(unsigned, v); }
__device__ __forceinline__ bf16_t f2bf(float f) { return (bf16_t)(cvt_pk_bf16(f, 0.f) & 0xffffu); }
__device__ __forceinline__ float bf_lo(unsigned u) { return __uint_as_float(u << 16); }
__device__ __forceinline__ float bf_hi(unsigned u) { return __uint_as_float(u & 0xffff0000u); }
__device__ __forceinline__ float bf2f(bf16_t b) { return __uint_as_float(((unsigned)b) << 16); }
__device__ __forceinline__ float fsigmoid(float x) { return __builtin_amdgcn_rcpf(1.0f + __expf(-x)); }
__device__ __forceinline__ float ftanh(float x) { x = fminf(fmaxf(x, -15.f), 15.f); const float e = __expf(2.0f * x); return 1.0f - 2.0f * __builtin_amdgcn_rcpf(e + 1.0f); }
__device__ __forceinline__ float fsilu(float x) { return x * fsigmoid(x); }
template <int CTRL> __device__ __forceinline__ float dppf(float x) { return __builtin_bit_cast(float, __builtin_amdgcn_mov_dpp(__builtin_bit_cast(int, x), CTRL, 0xf, 0xf, true)); }
__device__ __forceinline__ float row16_sum(float v) { v += dppf<0xB1>(v); v += dppf<0x4E>(v); v += dppf<0x141>(v); v += dppf<0x140>(v); return v; }
__device__ __forceinline__ float row8_sum(float v) { v += dppf<0xB1>(v); v += dppf<0x4E>(v); v += dppf<0x141>(v); return v; }
__device__ __forceinline__ float wave_sum_l63(float v) {
    v = row16_sum(v);
    v += __builtin_bit_cast(float, __builtin_amdgcn_update_dpp(0, __builtin_bit_cast(int, v), 0x142, 0xa, 0xf, false));
    v += __builtin_bit_cast(float, __builtin_amdgcn_update_dpp(0, __builtin_bit_cast(int, v), 0x143, 0xc, 0xf, false));
    return v; }
__device__ __forceinline__ float wave_sum(float v) { return __builtin_bit_cast(float, __builtin_amdgcn_readlane(__builtin_bit_cast(int, wave_sum_l63(v)), 63)); }
#define LDS_WAIT() asm volatile("s_waitcnt lgkmcnt(0)" ::: "memory")
#define VM_WAIT() asm volatile("s_waitcnt vmcnt(0)" ::: "memory")

#define XB_TMO      128
#define XB_XCNT(j)  (256  + 64 * (j))
#define XB_XSUB(j)  (1280 + 64 * (j))
#define XB_XGEN(j)  (2304 + 64 * (j))
#define XB_TOP      3328
#define XB_TOPGEN   3392
#define XCD_BAR_WORDS 3456
#define XB_SPIN_CAP (1u << 18)

__device__ __forceinline__ unsigned xb_ld(unsigned* p)              { return __hip_atomic_load(p, __ATOMIC_RELAXED, __HIP_MEMORY_SCOPE_AGENT); }
__device__ __forceinline__ unsigned xb_add(unsigned* p, unsigned v) { return __hip_atomic_fetch_add(p, v, __ATOMIC_RELAXED, __HIP_MEMORY_SCOPE_AGENT); }
__device__ __forceinline__ unsigned xb_xcc_id() { return (unsigned)__builtin_amdgcn_s_getreg((3 << 11) | 20) & 0xFu; }
#define XB_SPIN(cond, bar) do { unsigned _sp = 0; while (cond) { __builtin_amdgcn_s_sleep(1); \
    if ((++_sp & 255u) == 0u) { if (xb_ld(&(bar)[XB_TMO])) break; if (_sp > XB_SPIN_CAP) { atomicAdd(&(bar)[XB_TMO], 1u); break; } } } } while (0)

struct XcdBarrier {
    unsigned* bar; unsigned x;
    volatile LAS unsigned* st;
};

__device__ __forceinline__ XcdBarrier xcd_barrier_post(unsigned* bar, volatile LAS unsigned* st) {
    XcdBarrier b; b.bar = bar; b.x = xb_xcc_id(); b.st = st;
    if (threadIdx.x == 0) (void)xb_add(&bar[XB_XCNT(b.x)], 1u);
    return b;
}
__device__ __forceinline__ void xcd_barrier_complete(unsigned* bar, unsigned x, unsigned& nloc, unsigned& nx) {
    const unsigned G = gridDim.x * gridDim.y * gridDim.z;
    unsigned sum, cnt, mine, sp = 0u;
    for (;;) {
        sum = 0u; cnt = 0u; mine = 0u;
#pragma unroll
        for (unsigned j = 0; j < 16; ++j) { const unsigned c = xb_ld(&bar[XB_XCNT(j)]); sum += c; cnt += (c > 0u) ? 1u : 0u; mine = (j == x) ? c : mine; }
        if (sum == G) break;
        __builtin_amdgcn_s_sleep(1);
        if ((++sp & 255u) == 0u) { if (xb_ld(&bar[XB_TMO])) break; if (sp > XB_SPIN_CAP) { atomicAdd(&bar[XB_TMO], 1u); break; } }
    }
    nloc = mine > 0u ? mine : 1u; nx = cnt > 0u ? cnt : 1u;
}

__device__ __forceinline__ void xcd_barrier(const XcdBarrier& b) {
    asm volatile("s_waitcnt vmcnt(0)" ::: "memory");
    __syncthreads();
    if (threadIdx.x == 0) {
        unsigned* bar = b.bar;
        __builtin_amdgcn_s_waitcnt(0);
        unsigned nloc = b.st[0], nx = b.st[1];
        if (nloc == 0u) { xcd_barrier_complete(bar, b.x, nloc, nx); b.st[0] = nloc; b.st[1] = nx; }
        const unsigned old = xb_add(&bar[XB_XSUB(b.x)], 1u);
        const unsigned gen = old / nloc;
        if (old + 1u == (gen + 1u) * nloc) {
            __builtin_amdgcn_fence(__ATOMIC_RELEASE, "agent");
            asm volatile("s_waitcnt vmcnt(0)" ::: "memory");
            const unsigned og = xb_add(&bar[XB_TOP], 1u);
            const unsigned tg = og / nx;
            if (og + 1u == (tg + 1u) * nx) xb_add(&bar[XB_TOPGEN], 1u);
            else XB_SPIN(xb_ld(&bar[XB_TOPGEN]) == tg, bar);
            __builtin_amdgcn_fence(__ATOMIC_ACQUIRE, "agent");
            xb_add(&bar[XB_XGEN(b.x)], 1u);
            asm volatile("s_waitcnt vmcnt(0)" ::: "memory");
        } else {
            XB_SPIN(xb_ld(&bar[XB_XGEN(b.x)]) == gen, bar);
            __builtin_amdgcn_fence(__ATOMIC_ACQUIRE, "agent");
            asm volatile("s_waitcnt vmcnt(0)" ::: "memory");
        }
    }
    __syncthreads();
}

namespace pg8 {
#ifndef MK_SP2
#define MK_SP2 1
#endif
constexpr bool PG8_SP2 = MK_SP2 != 0;
constexpr int BM = 256, BK = 64, HALF = 128, HTB = HALF * BK * 2  , STAGE_BYTES = 8 * HTB, NXCD = 8;
__device__ __forceinline__ int lds_byte(int r, int c) { const int st = (r >> 4) * 2 + (c >> 5), rr = r & 15, cc = c & 31, ob = rr * 64 + cc * 2; return st * 1024 + (ob ^ (((ob >> 9) & 1) << 5)); }
__device__ __forceinline__ void stage_rc(int b, int& R, int& C) { const int st = b / 1024, sb = b % 1024, swz = sb ^ (((sb >> 9) & 1) << 5); R = (st >> 1) * 16 + swz / 64; C = (st & 1) * 32 + (swz % 64) / 2; }
__device__ __forceinline__ int perm32(int rho) { const int n = rho >> 4, i = rho & 15; return 8 * (i >> 2) + 4 * n + (i & 3); }

struct Unit { int pm, pn, e; };

__device__ __forceinline__ int xcd_remap(int L, int nwg) { const int q = nwg / NXCD, r = nwg % NXCD, xcd = L % NXCD, off = L / NXCD; return (xcd < r ? xcd * (q + 1) : r * (q + 1) + (xcd - r) * q) + off; }

template <int K, class Epi, class Sched>
__device__ __forceinline__ void gemm_phase(LAS unsigned char* lds, const Sched& S, const Epi& E) {
    const int tid = threadIdx.x, wid = __builtin_amdgcn_readfirstlane(tid >> 6), lane = tid & 63, wr = wid >> 2, wc = wid & 3, fr = lane & 15, fq = lane >> 4;
    constexpr int nt = K / BK;
    static_assert(K % 128 == 0 && K >= 256, "K");
    int Rr[2], Cc[2]; unsigned voffB[2];
#pragma unroll
    for (int i = 0; i < 2; ++i) { stage_rc(tid * 16 + i * 8192, Rr[i], Cc[i]); const int Rb = Epi::PERM == 2 ? ((Rr[i] >> 5) * 64 + perm32(Rr[i] & 31)) : Epi::PERM == 1 ? ((Rr[i] & ~31) + perm32(Rr[i] & 31)) : Rr[i]; voffB[i] = (unsigned)(Rb * K + Cc[i]) * 2u; }
    constexpr unsigned hstepB = (unsigned)(Epi::PERM == 2 ? 32 : HALF) * K * 2;
    const unsigned ldsw = (unsigned)wid * 1024u;
    const int aoff = lds_byte(wr * 64 + fr, fq * 8), boff = lds_byte(wc * 32 + fr, fq * 8);
#define PG8_SA(b, h) (((b) * 2 + (h)) * HTB)
#define PG8_SB(b, h) ((4 + (b) * 2 + (h)) * HTB)
#define PG8_STAGE_A(bufoff, base, offs, h, kb) do { _Pragma("unroll") for (int _i = 0; _i < 2; ++_i) \
        __builtin_amdgcn_global_load_lds((const unsigned*)((base) + (size_t)((offs)[h][_i] + (unsigned)(kb))), (LAS unsigned*)(lds + (bufoff) + ldsw + _i * 8192), 16, 0, 0); } while (0)
#define PG8_STAGE_B(bufoff, base, h, kb) do { _Pragma("unroll") for (int _i = 0; _i < 2; ++_i) \
        __builtin_amdgcn_global_load_lds((const unsigned*)((base) + (size_t)(voffB[_i] + (unsigned)(h) * hstepB + (unsigned)(kb))), (LAS unsigned*)(lds + (bufoff) + ldsw + _i * 8192), 16, 0, 0); } while (0)
#define PG8_LDA(dst, b, h) do { _Pragma("unroll") for (int m = 0; m < 4; ++m) _Pragma("unroll") for (int k = 0; k < 2; ++k) dst[m][k] = *(const LAS bf16x8*)(lds + PG8_SA(b, h) + aoff + m * 2048 + k * 1024); } while (0)
#define PG8_LDB(dst, b, h) do { _Pragma("unroll") for (int n = 0; n < 2; ++n) _Pragma("unroll") for (int k = 0; k < 2; ++k) dst[n][k] = *(const LAS bf16x8*)(lds + PG8_SB(b, h) + boff + n * 2048 + k * 1024); } while (0)
#define PG8_MMA(ai, bj, At, Bt) do { __builtin_amdgcn_s_setprio(1); _Pragma("unroll") for (int m = 0; m < 4; ++m) _Pragma("unroll") for (int n = 0; n < 2; ++n) _Pragma("unroll") for (int k = 0; k < 2; ++k) \
        acc[ai][bj][m][n] = __builtin_amdgcn_mfma_f32_16x16x32_bf16(Bt[n][k], At[m][k], acc[ai][bj][m][n], 0, 0, 0); __builtin_amdgcn_s_setprio(0); } while (0)
#define PG8_WAIT_V(n) asm volatile("s_waitcnt vmcnt(" #n ")" ::: "memory")
#define PG8_WAIT_L(n) asm volatile("s_waitcnt lgkmcnt(" #n ")" ::: "memory")
#define PG8_BAR __builtin_amdgcn_s_barrier()
#define PG8_SCHED __builtin_amdgcn_sched_barrier(0)
    Unit cur, nxt; int ui = 0;
    if (!S.next(0, cur)) return;
    f32x4 acc[2][2][4][2];
#pragma unroll
    for (int a = 0; a < 2; ++a)
#pragma unroll
        for (int b = 0; b < 2; ++b)
#pragma unroll
            for (int m = 0; m < 4; ++m)
#pragma unroll
                for (int n = 0; n < 2; ++n) acc[a][b][m][n] = (f32x4){0.f, 0.f, 0.f, 0.f};
    bf16x8 At[4][2], B0[2][2], B1[2][2];
    unsigned cAo[2][2], nAo[2][2];
#pragma unroll
    for (int h = 0; h < 2; ++h)
#pragma unroll
        for (int i = 0; i < 2; ++i) {
            if constexpr (Sched::GATHER) cAo[h][i] = S.a_rowoff(cur, h * HALF + Rr[i]) + (unsigned)Cc[i] * 2u;
            else cAo[h][i] = (unsigned)((h * HALF + Rr[i]) * K + Cc[i]) * 2u;
            nAo[h][i] = cAo[h][i];
        }
    const char* cA = S.a_base(cur); const char* cB = S.b_base(cur);
    if constexpr (PG8_SP2) {
        PG8_STAGE_B(PG8_SB(0, 0), cB, 0, 0); PG8_STAGE_B(PG8_SB(0, 1), cB, 1, 0); PG8_STAGE_A(PG8_SA(0, 0), cA, cAo, 0, 0); PG8_STAGE_A(PG8_SA(0, 1), cA, cAo, 1, 0);
        if (wr == 1) PG8_BAR;
        PG8_WAIT_V(2); PG8_BAR;
        PG8_STAGE_B(PG8_SB(1, 0), cB, 0, 128); PG8_STAGE_A(PG8_SA(1, 0), cA, cAo, 0, 128); PG8_STAGE_B(PG8_SB(1, 1), cB, 1, 128);
        PG8_WAIT_V(6); PG8_BAR;
    } else {
    PG8_STAGE_B(PG8_SB(0, 0), cB, 0, 0); PG8_STAGE_A(PG8_SA(0, 0), cA, cAo, 0, 0); PG8_STAGE_B(PG8_SB(0, 1), cB, 1, 0); PG8_STAGE_A(PG8_SA(0, 1), cA, cAo, 1, 0);
    if (wr == 1) PG8_BAR;
    PG8_WAIT_V(4); PG8_BAR;
    PG8_STAGE_B(PG8_SB(1, 0), cB, 0, 128); PG8_STAGE_A(PG8_SA(1, 0), cA, cAo, 0, 128); PG8_STAGE_B(PG8_SB(1, 1), cB, 1, 128);
    PG8_WAIT_V(6); PG8_BAR;
    }
    for (;;) {
        const bool has_next = S.next(ui + 1, nxt);
        const char* nA = has_next ? S.a_base(nxt) : cA; const char* nB = has_next ? S.b_base(nxt) : cB;
        if constexpr (Sched::GATHER) {
#pragma unroll
            for (int h = 0; h < 2; ++h)
#pragma unroll
                for (int i = 0; i < 2; ++i) nAo[h][i] = has_next ? (S.a_rowoff(nxt, h * HALF + Rr[i]) + (unsigned)Cc[i] * 2u) : cAo[h][i];
        }
#pragma unroll 1
        for (int t = 0; t < nt; t += 2) {
            const bool last = (t == nt - 2);
            const unsigned k1 = (unsigned)(t + 1) * 128u;
            const char* a2 = last ? nA : cA; const char* b2 = last ? nB : cB;
            const unsigned k2 = last ? 0u : (unsigned)(t + 2) * 128u, k3 = k2 + 128u;
            unsigned a2o[2][2];
#pragma unroll
            for (int h = 0; h < 2; ++h)
#pragma unroll
                for (int i = 0; i < 2; ++i) { if constexpr (Sched::GATHER) a2o[h][i] = last ? nAo[h][i] : cAo[h][i]; else a2o[h][i] = cAo[h][i]; }
            if constexpr (PG8_SP2) {
            PG8_LDB(B0, 0, 0); PG8_LDB(B1, 0, 1); PG8_SCHED; PG8_LDA(At, 0, 0); PG8_STAGE_A(PG8_SA(1, 1), cA, cAo, 1, k1);
            PG8_WAIT_V(8); PG8_WAIT_L(0); PG8_BAR; PG8_MMA(0, 0, At, B0); PG8_MMA(0, 1, At, B1); PG8_BAR; PG8_SCHED;
            PG8_LDA(At, 0, 1); PG8_STAGE_B(PG8_SB(0, 0), b2, 0, k2); PG8_STAGE_B(PG8_SB(0, 1), b2, 1, k2); PG8_STAGE_A(PG8_SA(0, 0), a2, a2o, 0, k2);
            PG8_WAIT_V(8); PG8_WAIT_L(0); PG8_BAR; PG8_MMA(1, 0, At, B0); PG8_MMA(1, 1, At, B1); PG8_BAR; PG8_SCHED;
            PG8_LDB(B0, 1, 0); PG8_LDB(B1, 1, 1); PG8_SCHED; PG8_LDA(At, 1, 0); PG8_STAGE_A(PG8_SA(0, 1), a2, a2o, 1, k2);
            PG8_WAIT_V(8); PG8_WAIT_L(0); PG8_BAR; PG8_MMA(0, 0, At, B0); PG8_MMA(0, 1, At, B1); PG8_BAR; PG8_SCHED;
            PG8_LDA(At, 1, 1); PG8_STAGE_B(PG8_SB(1, 0), b2, 0, k3); PG8_STAGE_B(PG8_SB(1, 1), b2, 1, k3); PG8_STAGE_A(PG8_SA(1, 0), a2, a2o, 0, k3);
            PG8_WAIT_V(8); PG8_WAIT_L(0); PG8_BAR; PG8_MMA(1, 0, At, B0); PG8_MMA(1, 1, At, B1); PG8_BAR; PG8_SCHED;
            } else {
            PG8_LDB(B0, 0, 0); PG8_SCHED; PG8_LDA(At, 0, 0); PG8_STAGE_A(PG8_SA(1, 1), cA, cAo, 1, k1);
            PG8_WAIT_L(8); PG8_BAR; PG8_WAIT_L(0); PG8_MMA(0, 0, At, B0); PG8_BAR; PG8_SCHED;
            PG8_LDB(B1, 0, 1); PG8_STAGE_B(PG8_SB(0, 0), b2, 0, k2);
            PG8_BAR; PG8_WAIT_L(0); PG8_MMA(0, 1, At, B1); PG8_BAR;
            PG8_LDA(At, 0, 1); PG8_STAGE_A(PG8_SA(0, 0), a2, a2o, 0, k2);
            PG8_BAR; PG8_WAIT_L(0); PG8_MMA(1, 0, At, B0); PG8_BAR; PG8_SCHED;
            PG8_STAGE_B(PG8_SB(0, 1), b2, 1, k2);
            PG8_WAIT_V(6); PG8_BAR; PG8_MMA(1, 1, At, B1); PG8_BAR;
            PG8_LDB(B0, 1, 0); PG8_SCHED; PG8_LDA(At, 1, 0); PG8_STAGE_A(PG8_SA(0, 1), a2, a2o, 1, k2);
            PG8_WAIT_L(8); PG8_BAR; PG8_WAIT_L(0); PG8_MMA(0, 0, At, B0); PG8_BAR; PG8_SCHED;
            PG8_LDB(B1, 1, 1); PG8_STAGE_B(PG8_SB(1, 0), b2, 0, k3);
            PG8_BAR; PG8_WAIT_L(0); PG8_MMA(0, 1, At, B1); PG8_BAR;
            PG8_LDA(At, 1, 1); PG8_STAGE_A(PG8_SA(1, 0), a2, a2o, 0, k3);
            PG8_BAR; PG8_WAIT_L(0); PG8_MMA(1, 0, At, B0); PG8_BAR; PG8_SCHED;
            PG8_STAGE_B(PG8_SB(1, 1), b2, 1, k3);
            PG8_WAIT_V(6); PG8_BAR; PG8_MMA(1, 1, At, B1); PG8_BAR;
            }
        }
        if (wr == 0) PG8_BAR;
        E(acc, cur, wr, wc, fr, fq);
        if constexpr (Epi::DUPE) { asm volatile("" ::: "memory"); E(acc, cur, wr, wc, fr, fq); }
        if (!has_next) break;
#pragma unroll
        for (int a = 0; a < 2; ++a)
#pragma unroll
            for (int b = 0; b < 2; ++b)
#pragma unroll
                for (int m = 0; m < 4; ++m)
#pragma unroll
                    for (int n = 0; n < 2; ++n) acc[a][b][m][n] = (f32x4){0.f, 0.f, 0.f, 0.f};
        cur = nxt; cA = nA; cB = nB; ++ui;
        if constexpr (Sched::GATHER) {
#pragma unroll
            for (int h = 0; h < 2; ++h)
#pragma unroll
                for (int i = 0; i < 2; ++i) cAo[h][i] = nAo[h][i];
        }
        if (wr == 1) PG8_BAR;
    }
    PG8_WAIT_V(0);
    PG8_BAR;
#undef PG8_SA
#undef PG8_SB
#undef PG8_STAGE_A
#undef PG8_STAGE_B
#undef PG8_LDA
#undef PG8_LDB
#undef PG8_MMA
#undef PG8_WAIT_V
#undef PG8_WAIT_L
#undef PG8_BAR
#undef PG8_SCHED
}
}

struct Args { const float* in[32]; float* out; unsigned char* ws; int ph_lo, ph_hi; };
enum { I_X = 0, I_C, I_ADAW, I_ADAB, I_MIXNW, I_WIN, I_MU, I_W0, I_WUP, I_A0, I_AUP, I_GUP, I_KK, I_KA, I_RK, I_GNW, I_GNB, I_CONVW, I_CONVB, I_IB, I_FB, I_HNW, I_WOUT, I_FFNNW,
       I_WGRP, I_BGRP, I_WRT, I_BRT, I_WGATE, I_WUPE, I_WDOWN, I_FINW };

struct Frame {
    LAS unsigned char* lds;
    const float* const* in; float* out; unsigned char* ws;
    int tid, lane, wave, bid, G;
};

__device__ __forceinline__ void p0_transpose_item(const float* W, int ldw, int K, int k0, int ncol0, bf16_t* WT, int drow0, LAS float* scr, int lane) {
#pragma unroll 8
    for (int i = 0; i < 32; ++i) { const int kk = 2 * i + (lane >> 5); scr[kk * 33 + (lane & 31)] = W[(size_t)(k0 + kk) * ldw + ncol0 + (lane & 31)]; }
    LDS_WAIT(); asm volatile("" ::: "memory");
    const int c = lane & 7;
#pragma unroll
    for (int j = 0; j < 4; ++j) { const int n = (lane >> 3) + 8 * j; const LAS float* s = scr + (8 * c) * 33 + n;
        u32x4 o; o.x = cvt_pk_bf16(s[0 * 33], s[1 * 33]); o.y = cvt_pk_bf16(s[2 * 33], s[3 * 33]); o.z = cvt_pk_bf16(s[4 * 33], s[5 * 33]); o.w = cvt_pk_bf16(s[6 * 33], s[7 * 33]);
        *(u32x4*)(WT + (size_t)(drow0 + n) * K + k0 + 8 * c) = o; }
    LDS_WAIT(); asm volatile("" ::: "memory");
}
__device__ __forceinline__ void p0_tr_plain(const float* W, int ldw, int K, int N, bf16_t* WT, int r, LAS float* scr, int lane) {
    const int nblk = N / 32, kb = r / nblk, nb = r % nblk;
    p0_transpose_item(W, ldw, K, 64 * kb, 32 * nb, WT, 32 * nb, scr, lane);
}
__device__ __forceinline__ void p0_prologue(Frame& F) {
    const float* c = F.in[I_C]; const float* ada_w = F.in[I_ADAW]; const float* ada_b = F.in[I_ADAB];
    float* mod = (float*)(F.ws + WS_MOD);
    if (F.bid < 96) {
        constexpr int LDWm = 72, LDSm = 136;
        LAS bf16_t* Wh = (LAS bf16_t*)F.lds;
        LAS bf16_t* Wl = Wh + 128 * LDWm;
        LAS bf16_t* Sh = Wl + 128 * LDWm;
        LAS bf16_t* Sl = Sh + 32 * LDSm;
        const int col0 = F.bid * 64;
        const int wk = F.tid >> 2, wq = F.tid & 3;
        const int sb = F.tid >> 4, sk = (F.tid & 15) * 8;
        const int fr = F.lane & 15, fq = F.lane >> 4;
        const int mtm = F.wave >> 1, ntm = F.wave & 1;
        f32x4 accm = {0.f, 0.f, 0.f, 0.f};
        f32x4 wreg[4], creg[2];
#define MOD_LOAD(KC) do { const float* wp_ = ada_w + (size_t)((KC) * 128 + wk) * 6144 + col0 + wq * 16; \
            _Pragma("unroll") for (int q_ = 0; q_ < 4; ++q_) wreg[q_] = *(const f32x4*)(wp_ + 4 * q_); \
            const float* cp_ = c + sb * 1024 + (KC) * 128 + sk; creg[0] = *(const f32x4*)cp_; creg[1] = *(const f32x4*)(cp_ + 4); } while (0)
        MOD_LOAD(0);
#pragma unroll 1
        for (int kc = 0; kc < 8; ++kc) {
            __syncthreads();
            { float wv[16];
#pragma unroll
              for (int q = 0; q < 4; ++q) { wv[4 * q] = wreg[q].x; wv[4 * q + 1] = wreg[q].y; wv[4 * q + 2] = wreg[q].z; wv[4 * q + 3] = wreg[q].w; }
              unsigned ph[8], pl[8];
#pragma unroll
              for (int q = 0; q < 8; ++q) { const unsigned h2 = cvt_pk_bf16(wv[2 * q], wv[2 * q + 1]); ph[q] = h2; pl[q] = cvt_pk_bf16(wv[2 * q] - bf_lo(h2), wv[2 * q + 1] - bf_hi(h2)); }
              *(LAS u32x4*)(Wh + wk * LDWm + wq * 16) = (u32x4){ph[0], ph[1], ph[2], ph[3]}; *(LAS u32x4*)(Wh + wk * LDWm + wq * 16 + 8) = (u32x4){ph[4], ph[5], ph[6], ph[7]};
              *(LAS u32x4*)(Wl + wk * LDWm + wq * 16) = (u32x4){pl[0], pl[1], pl[2], pl[3]}; *(LAS u32x4*)(Wl + wk * LDWm + wq * 16 + 8) = (u32x4){pl[4], pl[5], pl[6], pl[7]};
              float sv[8] = {creg[0].x, creg[0].y, creg[0].z, creg[0].w, creg[1].x, creg[1].y, creg[1].z, creg[1].w};
              unsigned qh[4], ql[4];
#pragma unroll
              for (int q = 0; q < 8; ++q) sv[q] = sv[q] / (1.0f + __expf(-sv[q]));
#pragma unroll
              for (int q = 0; q < 4; ++q) { const unsigned h2 = cvt_pk_bf16(sv[2 * q], sv[2 * q + 1]); qh[q] = h2; ql[q] = cvt_pk_bf16(sv[2 * q] - bf_lo(h2), sv[2 * q + 1] - bf_hi(h2)); }
              *(LAS u32x4*)(Sh + sb * LDSm + sk) = (u32x4){qh[0], qh[1], qh[2], qh[3]}; *(LAS u32x4*)(Sl + sb * LDSm + sk) = (u32x4){ql[0], ql[1], ql[2], ql[3]}; }
            if (kc + 1 < 8) MOD_LOAD(kc + 1);
            __syncthreads();
#pragma unroll
            for (int ks = 0; ks < 4; ++ks) {
                bf16x8 ah, al;
                { const LAS bf16_t* p_ = Wh + (ks * 32 + 8 * fq + (fr >> 2)) * LDWm + 16 * mtm + 4 * (fr & 3);
                  const s16x4 lo_ = __builtin_amdgcn_ds_read_tr16_b64_v4i16((LAS s16x4*)p_), hi_ = __builtin_amdgcn_ds_read_tr16_b64_v4i16((LAS s16x4*)(p_ + 4 * LDWm)); ah = __builtin_shufflevector(lo_, hi_, 0, 1, 2, 3, 4, 5, 6, 7); }
                { const LAS bf16_t* p_ = Wl + (ks * 32 + 8 * fq + (fr >> 2)) * LDWm + 16 * mtm + 4 * (fr & 3);
                  const s16x4 lo_ = __builtin_amdgcn_ds_read_tr16_b64_v4i16((LAS s16x4*)p_), hi_ = __builtin_amdgcn_ds_read_tr16_b64_v4i16((LAS s16x4*)(p_ + 4 * LDWm)); al = __builtin_shufflevector(lo_, hi_, 0, 1, 2, 3, 4, 5, 6, 7); }
                const bf16x8 bh = *(const LAS bf16x8*)(Sh + (ntm * 16 + fr) * LDSm + ks * 32 + fq * 8), bl = *(const LAS bf16x8*)(Sl + (ntm * 16 + fr) * LDSm + ks * 32 + fq * 8);
                accm = __builtin_amdgcn_mfma_f32_16x16x32_bf16(ah, bh, accm, 0, 0, 0);
                accm = __builtin_amdgcn_mfma_f32_16x16x32_bf16(ah, bl, accm, 0, 0, 0);
                accm = __builtin_amdgcn_mfma_f32_16x16x32_bf16(al, bh, accm, 0, 0, 0);
            }
        }
#undef MOD_LOAD
        { const int colw = col0 + mtm * 16 + fq * 4, bw = ntm * 16 + fr;
          const f32x4 bb = *(const f32x4*)(ada_b + colw);
          *(f32x4*)(mod + (size_t)bw * 6144 + colw) = accm + bb; }
        __syncthreads();
    }
    if (F.wave == NWAVES - 1) { const float* win = F.in[I_WIN]; float* gwc = (float*)(F.ws + WS_GW);
        for (int blk = F.G - 1 - F.bid; blk < 128; blk += F.G) { const int i = blk * 64 + F.lane; const int g = i & 7, k = i >> 3; gwc[g * 1024 + k] = win[(size_t)k * IN_COLS + NPROJ + g]; } }
    LAS float* scr = (LAS float*)(F.lds + F.wave * 16384);
    const int gw = F.bid * NWAVES + F.wave, NGW = F.G * NWAVES;
    bf16_t* WINT = (bf16_t*)(F.ws + WS_WIN); bf16_t* WOUTT = (bf16_t*)(F.ws + WS_WOUT); bf16_t* W1T = (bf16_t*)(F.ws + WS_W1); bf16_t* W2T = (bf16_t*)(F.ws + WS_W2);
    bf16_t* WUPT = (bf16_t*)(F.ws + WS_LORA); bf16_t* AUPT = WUPT + 512 * 64; bf16_t* GUPT = AUPT + 512 * 64;
    constexpr int I_IN = 16 * 104, I_OUT = 16 * 32, I_G = 32 * 16 * 8, I_U = I_G, I_D = 32 * 4 * 32, I_L1 = 16, I_L2 = 16, I_L3 = 32;
    constexpr int NITEMS = I_IN + I_OUT + I_G + I_U + I_D + I_L1 + I_L2 + I_L3;
    struct Desc { const float* W; bf16_t* WT; int ldw, K, k0, n0, drow0; };
    auto plain = [](const float* W, int ldw, int K, int N, bf16_t* WT, int r) { const int nblk = N / 32, kb = r / nblk, nb = r % nblk; return Desc{W, WT, ldw, K, 64 * kb, 32 * nb, 32 * nb}; };
    auto desc = [&](int it) -> Desc {
        int r = it;
        if (r < I_IN) return plain(F.in[I_WIN], IN_COLS, 1024, NPROJ, WINT, r); r -= I_IN;
        if (r < I_OUT) return plain(F.in[I_WOUT], 1024, 1024, 1024, WOUTT, r); r -= I_OUT;
        if (r < I_G + I_U) {
            const int isup = r >= I_G; if (isup) r -= I_G;
            const int e = r / 128, rr = r % 128, kb = rr / 8, nb = rr % 8;
            const float* W = (isup ? F.in[I_WUPE] : F.in[I_WGATE]) + (size_t)e * 1024 * 256;
            const int f0 = 32 * nb, drow0 = (f0 >> 7) * 256 + (isup ? 128 : 0) + (f0 & 127);
            return Desc{W, W1T + (size_t)e * 512 * 1024, 256, 1024, 64 * kb, f0, drow0}; }
        r -= I_G + I_U;
        if (r < I_D) { const int e = r / 128, rr = r % 128; return plain(F.in[I_WDOWN] + (size_t)e * 256 * 1024, 1024, 256, 1024, W2T + (size_t)e * 1024 * 256, rr); } r -= I_D;
        if (r < I_L1) return plain(F.in[I_WUP], 512, 64, 512, WUPT, r); r -= I_L1;
        if (r < I_L2) return plain(F.in[I_AUP], 512, 64, 512, AUPT, r); r -= I_L2;
        return plain(F.in[I_GUP], 512, 128, 512, GUPT, r);
    };
    const int lane = F.lane;
#define P0_LOAD(D, V) do { _Pragma("unroll") for (int i = 0; i < 32; ++i) V[i] = __builtin_nontemporal_load(&(D).W[(size_t)((D).k0 + 2 * i + (lane >> 5)) * (D).ldw + (D).n0 + (lane & 31)]); } while (0)
#define P0_FINISH(D, V) do { _Pragma("unroll") for (int i = 0; i < 32; ++i) scr[(2 * i + (lane >> 5)) * 33 + (lane & 31)] = V[i]; \
        LDS_WAIT(); asm volatile("" ::: "memory"); \
        const int c_ = lane & 7; \
        _Pragma("unroll") for (int j = 0; j < 4; ++j) { const int n_ = (lane >> 3) + 8 * j; const LAS float* s_ = scr + (8 * c_) * 33 + n_; \
            u32x4 o_; o_.x = cvt_pk_bf16(s_[0 * 33], s_[1 * 33]); o_.y = cvt_pk_bf16(s_[2 * 33], s_[3 * 33]); o_.z = cvt_pk_bf16(s_[4 * 33], s_[5 * 33]); o_.w = cvt_pk_bf16(s_[6 * 33], s_[7 * 33]); \
            *(u32x4*)((D).WT + (size_t)((D).drow0 + n_) * (D).K + (D).k0 + 8 * c_) = o_; } \
        LDS_WAIT(); asm volatile("" ::: "memory"); } while (0)
    constexpr int P0_HEAD = 4;
    const int W1 = (F.G - 96) * NWAVES, N1 = W1 > 0 ? P0_HEAD * W1 : 0;
    const int first2 = N1 + (NGW - 1 - gw);
    auto nxt = [&](int i) { if (i < N1) { const int n = i + W1; return n < N1 ? n : first2; } return i + NGW; };
    float va[32], vb[32];
    int it = (F.bid >= 96 && N1 > 0) ? (F.bid - 96) * NWAVES + F.wave : first2;
    if (it < NITEMS) { Desc da = desc(it); P0_LOAD(da, va);
        for (;;) {
            const int i1 = nxt(it); Desc db = da; if (i1 < NITEMS) { db = desc(i1); P0_LOAD(db, vb); }
            P0_FINISH(da, va);
            if (i1 >= NITEMS) break;
            const int i2 = nxt(i1); if (i2 < NITEMS) { da = desc(i2); P0_LOAD(da, va); }
            P0_FINISH(db, vb);
            if (i2 >= NITEMS) break;
            it = i2;
        } }
#undef P0_LOAD
#undef P0_FINISH
}

__device__ __forceinline__ void p1_norm1(Frame& F) {
    const float* x = F.in[I_X]; const float* nw = F.in[I_MIXNW]; const float* win = F.in[I_WIN];
    const float* mod = (const float*)(F.ws + WS_MOD);
    bf16_t* H = (bf16_t*)(F.ws + WS_H); float* gates = (float*)(F.ws + WS_GATES);
    LAS float* gwl = (LAS float*)F.lds;
    const int gw = F.bid * NWAVES + F.wave;
    const int b = gw >> 6; const int r0 = b * SEQ + (gw & 63);
    f32x4 g1v[4], shv[4];
#pragma unroll
    for (int j = 0; j < 4; ++j) { const f32x4 n4 = *(const f32x4*)(nw + 4 * F.lane + 256 * j), sc = *(const f32x4*)(mod + b * 6144 + 1024 + 4 * F.lane + 256 * j);
        g1v[j] = n4 * (sc + 1.0f); shv[j] = *(const f32x4*)(mod + b * 6144 + 4 * F.lane + 256 * j); }
    f32x4 xn[4];
    if (gw < NB * 64) { const float* xr0 = x + (size_t)r0 * D + 4 * F.lane;
#pragma unroll
        for (int j = 0; j < 4; ++j) xn[j] = __builtin_nontemporal_load((const f32x4*)(xr0 + 256 * j)); }
    { const f32x4* gwc = (const f32x4*)(F.ws + WS_GW); for (int i = F.tid; i < 2 * 1024; i += NTHR) ((LAS f32x4*)gwl)[i] = gwc[i]; }
    __syncthreads();
    for (int i = 0; i < 32 && gw < NB * 64; ++i) {
        const int m = r0 + 64 * i;
        f32x4 v[4]; float ss = 0.f;
#pragma unroll
        for (int j = 0; j < 4; ++j) { v[j] = xn[j]; ss += (v[j].x * v[j].x + v[j].y * v[j].y) + (v[j].z * v[j].z + v[j].w * v[j].w); }
        if (i + 1 < 32) { const float* xr1 = x + (size_t)(m + 64) * D + 4 * F.lane;
#pragma unroll
            for (int j = 0; j < 4; ++j) xn[j] = __builtin_nontemporal_load((const f32x4*)(xr1 + 256 * j)); }
        ss = wave_sum(ss);
        const float rstd = __builtin_amdgcn_rsqf(ss * (1.0f / D) + 1e-6f);
        float g8[8];
#pragma unroll
        for (int g = 0; g < 8; ++g) g8[g] = 0.f;
#pragma unroll
        for (int j = 0; j < 4; ++j) {
            f32x4 hv = (v[j] * rstd) * g1v[j] + shv[j];
            v[j] = hv;
#pragma unroll
            for (int g = 0; g < 8; ++g) { const f32x4 w = *(const LAS f32x4*)(gwl + g * 1024 + 4 * F.lane + 256 * j); g8[g] += (hv.x * w.x + hv.y * w.y) + (hv.z * w.z + hv.w * w.w); }
        }
        u32x2* o = (u32x2*)(H + (size_t)m * D + 4 * F.lane);
#pragma unroll
        for (int j = 0; j < 4; ++j) { u32x2 w; w.x = cvt_pk_bf16(v[j].x, v[j].y); w.y = cvt_pk_bf16(v[j].z, v[j].w); o[64 * j] = w; }
#pragma unroll
        for (int g = 0; g < 8; ++g) g8[g] = wave_sum_l63(g8[g]);
        if (F.lane == 63) { *(f32x4*)(gates + (size_t)m * 8) = (f32x4){g8[0], g8[1], g8[2], g8[3]}; *(f32x4*)(gates + (size_t)m * 8 + 4) = (f32x4){g8[4], g8[5], g8[6], g8[7]}; }
    }
}

template <int K> struct DenseOrder {
    static constexpr bool GATHER = false;
    const char* A; const char* Bt; int nM, nN, nwg, G, c, wgm;
    __device__ __forceinline__ void init(const void* A_, const void* Bt_, int M, int N, int G_, int c_, int wgm_ = 8) { A = (const char*)A_; Bt = (const char*)Bt_; nM = M / 256; nN = N / 256; nwg = nM * nN; G = G_; c = c_; wgm = wgm_; }
    __device__ __forceinline__ bool next(int i, pg8::Unit& u) const {
        const int L = i * G + c; if (L >= nwg) return false;
        const int wgid = pg8::xcd_remap(L, nwg);
        const int nig = wgm * nN, gid = wgid / nig, fm = gid * wgm, gsz = (nM - fm) < wgm ? (nM - fm) : wgm;
        u.pm = fm + ((wgid % nig) % gsz); u.pn = (wgid % nig) / gsz; u.e = 0; return true;
    }
    __device__ __forceinline__ const char* a_base(const pg8::Unit& u) const { return A + (size_t)u.pm * 256 * K * 2; }
    __device__ __forceinline__ const char* b_base(const pg8::Unit& u) const { return Bt + (size_t)u.pn * 256 * K * 2; }
    __device__ __forceinline__ unsigned a_rowoff(const pg8::Unit&, int) const { return 0u; }
};
__device__ __forceinline__ void st_rows128(bf16_t* rowp, size_t stride, u32x4 w0, u32x4 w1, bool odd) {
    u32x4 x, y;
#pragma unroll
    for (int e = 0; e < 4; ++e) { x[e] = odd ? w0[e] : w1[e]; y[e] = (unsigned)__builtin_amdgcn_mov_dpp((int)x[e], 0xB1, 0xf, 0xf, true); }
    u32x4 s1, s2;
#pragma unroll
    for (int e = 0; e < 4; ++e) { s1[e] = odd ? y[e] : w0[e]; s2[e] = odd ? w1[e] : y[e]; }
    bf16_t* pe = odd ? (rowp - stride + 32) : rowp;
    *(u32x4*)pe = s1; *(u32x4*)(pe + stride) = s2;
}
struct EpiProj {
    static constexpr int PERM = 2; static constexpr bool DUPE = (MK_DUP == 60);
    bf16_t* O;
    __device__ __forceinline__ void operator()(const f32x4 (&acc)[2][2][4][2], const pg8::Unit& u, int wr, int wc, int fr, int fq) const {
        const int row0 = u.pm * 256 + wr * 64 + fr, col0 = u.pn * 256 + wc * 64 + 8 * fq; const bool odd = fr & 1;
#pragma unroll
        for (int ai = 0; ai < 2; ++ai)
#pragma unroll
            for (int m = 0; m < 4; ++m) { bf16_t* rowp = O + (size_t)(row0 + ai * 128 + m * 16) * NPROJ + col0;
                u32x4 w[2];
#pragma unroll
                for (int bj = 0; bj < 2; ++bj) { const f32x4 v0 = acc[ai][bj][m][0], v1 = acc[ai][bj][m][1];
                    w[bj].x = cvt_pk_bf16(v0[0], v0[1]); w[bj].y = cvt_pk_bf16(v0[2], v0[3]); w[bj].z = cvt_pk_bf16(v1[0], v1[1]); w[bj].w = cvt_pk_bf16(v1[2], v1[3]); }
                st_rows128(rowp, NPROJ, w[0], w[1], odd); }
    }
};
struct EpiOut {
    static constexpr int PERM = 2; static constexpr bool DUPE = (MK_DUP == 61);
    const float* x; const float* mod; bf16_t* x1;
    __device__ __forceinline__ void operator()(const f32x4 (&acc)[2][2][4][2], const pg8::Unit& u, int wr, int wc, int fr, int fq) const {
        const int row0 = u.pm * 256 + wr * 64 + fr, col0 = u.pn * 256 + wc * 64 + 8 * fq; const bool odd = fr & 1;
        const int b = u.pm >> 3;
        f32x4 gm[2][2];
#pragma unroll
        for (int bj = 0; bj < 2; ++bj)
#pragma unroll
            for (int n = 0; n < 2; ++n) gm[bj][n] = *(const f32x4*)(mod + b * 6144 + 2048 + col0 + bj * 32 + n * 4);
#pragma unroll
        for (int ai = 0; ai < 2; ++ai)
#pragma unroll
            for (int m = 0; m < 4; ++m) { const size_t off = (size_t)(row0 + ai * 128 + m * 16) * D + col0;
                u32x4 w[2];
#pragma unroll
                for (int bj = 0; bj < 2; ++bj) { const f32x4 x0 = *(const f32x4*)(x + off + bj * 32), x4 = *(const f32x4*)(x + off + bj * 32 + 4);
                    const f32x4 v0 = x0 + gm[bj][0] * acc[ai][bj][m][0], v1 = x4 + gm[bj][1] * acc[ai][bj][m][1];
                    w[bj].x = cvt_pk_bf16(v0[0], v0[1]); w[bj].y = cvt_pk_bf16(v0[2], v0[3]); w[bj].z = cvt_pk_bf16(v1[0], v1[1]); w[bj].w = cvt_pk_bf16(v1[2], v1[3]); }
                st_rows128(x1 + off, D, w[0], w[1], odd); }
    }
};
struct MoeTab { const LAS int* tile_e; int ntiles; };
struct GateUpOrder {
    static constexpr bool GATHER = true;
    const char* A; const char* W1; const unsigned* slotE; const LAS int* start; MoeTab tab; int nwg, G, c;
    __device__ __forceinline__ bool next(int i, pg8::Unit& u) const {
        const int L = i * G + c; if (L >= nwg) return false;
        const int w = pg8::xcd_remap(L, nwg); u.pm = w >> 1; u.pn = w & 1; u.e = tab.tile_e[u.pm]; return true;
    }
    __device__ __forceinline__ const char* a_base(const pg8::Unit&) const { return A; }
    __device__ __forceinline__ const char* b_base(const pg8::Unit& u) const { return W1 + ((size_t)u.e * 512 + (size_t)u.pn * 256) * 1024 * 2; }
    __device__ __forceinline__ unsigned a_rowoff(const pg8::Unit& u, int r) const { const int e = u.e, idx = (u.pm - start[e]) * 256 + r;
        unsigned tok = 0u; if (idx < start[40 + e]) tok = slotE[(size_t)e * 65536 + idx] & 0xffffu; return tok * 2048u; }
};
struct EpiGateUp {
    static constexpr int PERM = 1; static constexpr bool DUPE = (MK_DUP == 62);
    bf16_t* Hact;
    __device__ __forceinline__ void operator()(const f32x4 (&acc)[2][2][4][2], const pg8::Unit& u, int wr, int wc, int fr, int fq) const {
        const int row0 = u.pm * 256 + wr * 64 + fr, col0 = u.pn * 128 + wc * 32 + 8 * fq;
#pragma unroll
        for (int ai = 0; ai < 2; ++ai)
#pragma unroll
            for (int m = 0; m < 4; ++m) { bf16_t* rowp = Hact + (size_t)(row0 + ai * 128 + m * 16) * 256 + col0;
                float o[8];
#pragma unroll
                for (int n = 0; n < 2; ++n)
#pragma unroll
                    for (int e = 0; e < 4; ++e) { const float g = acc[ai][0][m][n][e], up = acc[ai][1][m][n][e]; o[4 * n + e] = g * fsigmoid(g) * up; }
                u32x4 w; w.x = cvt_pk_bf16(o[0], o[1]); w.y = cvt_pk_bf16(o[2], o[3]); w.z = cvt_pk_bf16(o[4], o[5]); w.w = cvt_pk_bf16(o[6], o[7]);
                *(u32x4*)rowp = w; }
    }
};
struct DownOrder {
    static constexpr bool GATHER = false;
    const char* A; const char* W2; MoeTab tab; int nwg, G, c;
    __device__ __forceinline__ bool next(int i, pg8::Unit& u) const {
        const int L = i * G + c; if (L >= nwg) return false;
        const int w = pg8::xcd_remap(L, nwg); u.pm = w >> 2; u.pn = w & 3; u.e = tab.tile_e[u.pm]; return true;
    }
    __device__ __forceinline__ const char* a_base(const pg8::Unit& u) const { return A + (size_t)u.pm * 256 * 256 * 2; }
    __device__ __forceinline__ const char* b_base(const pg8::Unit& u) const { return W2 + ((size_t)u.e * 1024 + (size_t)u.pn * 256) * 256 * 2; }
    __device__ __forceinline__ unsigned a_rowoff(const pg8::Unit&, int) const { return 0u; }
};
struct EpiDown {
    static constexpr int PERM = 2; static constexpr bool DUPE = (MK_DUP == 63);
    bf16_t* moes;
    __device__ __forceinline__ void operator()(const f32x4 (&acc)[2][2][4][2], const pg8::Unit& u, int wr, int wc, int fr, int fq) const {
        const int row0 = u.pm * 256 + wr * 64 + fr, col0 = u.pn * 256 + wc * 64 + 8 * fq; const bool odd = fr & 1;
#pragma unroll
        for (int ai = 0; ai < 2; ++ai)
#pragma unroll
            for (int m = 0; m < 4; ++m) { bf16_t* rowp = moes + (size_t)(row0 + ai * 128 + m * 16) * D + col0;
                u32x4 w[2];
#pragma unroll
                for (int bj = 0; bj < 2; ++bj) { const f32x4 v0 = acc[ai][bj][m][0], v1 = acc[ai][bj][m][1];
                    w[bj].x = cvt_pk_bf16(v0[0], v0[1]); w[bj].y = cvt_pk_bf16(v0[2], v0[3]); w[bj].z = cvt_pk_bf16(v1[0], v1[1]); w[bj].w = cvt_pk_bf16(v1[2], v1[3]); }
                st_rows128(rowp, D, w[0], w[1], odd); }
    }
};


namespace rk {
constexpr int LD = 72;
constexpr int SLOT = 64 * LD * 2;
__device__ __forceinline__ bf16x8 frag(const LAS bf16_t* M, int row, int k) { return *(const LAS bf16x8*)(M + row * LD + k); }
__device__ __forceinline__ f32x4 mma(bf16x8 a, bf16x8 b, f32x4 c) { return __builtin_amdgcn_mfma_f32_16x16x32_bf16(a, b, c, 0, 0, 0); }
__device__ __forceinline__ void storeT(LAS bf16_t* Out, int mt, int nt, int fr, int fq, f32x4 v) {
    u32x2 w; w.x = cvt_pk_bf16(v[0], v[1]); w.y = cvt_pk_bf16(v[2], v[3]); *(LAS u32x2*)(Out + (nt * 16 + fr) * LD + mt * 16 + fq * 4) = w; }
__device__ __forceinline__ void storeRM(LAS bf16_t* Out, int mt, int nt, int fr, int fq, f32x4 v) {
#pragma unroll
    for (int r = 0; r < 4; ++r) Out[(mt * 16 + fq * 4 + r) * LD + nt * 16 + fr] = f2bf(v[r]); }
}
__device__ __forceinline__ void p3_rwkv_chunked(Frame& F) {
    using namespace rk;
    if (F.bid >= 256) return;
    const int b = F.bid >> 3, h = F.bid & 7;
    const bf16_t* proj = (const bf16_t*)(F.ws + WS_PROJ) + (size_t)b * SEQ * NPROJ;
    bf16_t* mix = (bf16_t*)(F.ws + WS_MIX) + (size_t)b * SEQ * D + h * 64;
    LAS unsigned char* L = F.lds;
#define RSLOT(i) ((LAS bf16_t*)(L + (i) * SLOT))
    LAS bf16_t* Sst = RSLOT(0);  LAS bf16_t* GG = RSLOT(1);
    LAS float* AabF = (LAS float*)RSLOT(2);
    LAS bf16_t* U0T = RSLOT(2);  LAS bf16_t* Gy = RSLOT(3);
    LAS bf16_t* AA = RSLOT(4);   LAS bf16_t* Aab = RSLOT(4); LAS bf16_t* MT = RSLOT(4);
    LAS bf16_t* At = RSLOT(5);   LAS bf16_t* Aw = RSLOT(5);
    LAS bf16_t* Bt = RSLOT(6);   LAS bf16_t* Ag = RSLOT(6);
    LAS bf16_t* Kt = RSLOT(7);
    LAS bf16_t* WT = RSLOT(8);
    LAS bf16_t* Rt = RSLOT(9);   LAS bf16_t* Aa = RSLOT(9);
    LAS bf16_t* PT = RSLOT(10);  LAS bf16_t* EB = RSLOT(10); LAS float* Yf = (LAS float*)RSLOT(10);
    LAS bf16_t* Tm = RSLOT(11);
    LAS bf16_t* Vm = RSLOT(12);
    LAS bf16_t* Aak = RSLOT(13); LAS float* LAMf = (LAS float*)RSLOT(13);
    LAS bf16_t* LWh = RSLOT(2); LAS bf16_t* LWl = RSLOT(3);
    LAS bf16_t* Arb = RSLOT(14); LAS bf16_t* Ark = RSLOT(15);
#undef RSLOT
    (void)Aw; (void)Aa; (void)Ag;
    LAS float* mu = (LAS float*)(L + 16 * SLOT);
    LAS float* prm = mu + 448;
    LAS float* bonus = prm + 448;
    LAS float* gL = bonus + 64;
    LAS float* et = (LAS float*)(L + MISC_OFF + 1024);
    LAS float* H0 = (LAS float*)(L + 155648);
    for (int i = F.tid; i < 448; i += NTHR) {
        int col; if (i < 64) col = C_R + h * 64 + i; else if (i < 128) col = C_K + h * 64 + (i - 64); else if (i < 192) col = C_V + h * 64 + (i - 128); else col = C_WD + (i - 192);
        mu[i] = F.in[I_MU][col]; }
    for (int i = F.tid; i < 448; i += NTHR) { const int w = i >> 6, j = i & 63;
        const float* src = w == 0 ? F.in[I_W0] : w == 1 ? F.in[I_A0] : w == 2 ? F.in[I_KK] : w == 3 ? F.in[I_KA] : w == 4 ? F.in[I_RK] : w == 5 ? F.in[I_GNW] : F.in[I_GNB];
        prm[i] = src[h * 64 + j]; }
    for (int i = F.tid; i < SLOT / 4; i += NTHR) ((LAS unsigned*)Sst)[i] = 0u;
    const int mt = F.wave >> 1, nt0 = (F.wave & 1) * 2;
#define RK_IDS() int tidv_ = F.tid; asm volatile("" : "+v"(tidv_)); const int lanev_ = tidv_ & 63; const int fr = lanev_ & 15, fq = lanev_ >> 4; const int tq = tidv_ >> 3, seg = tidv_ & 7, j0 = seg * 8; (void)fr; (void)fq; (void)tq; (void)seg; (void)j0
#define FRN(M, row, k) (*(const LAS bf16x8*)((M) + (row) * LD + (k)))
#define FRT(dst, M, k0, c0) do { const LAS bf16_t* p_ = (M) + ((k0) + 8 * fq + (fr >> 2)) * LD + (c0) + 4 * (fr & 3); \
        const s16x4 lo_ = __builtin_amdgcn_ds_read_tr16_b64_v4i16((LAS s16x4*)p_); const s16x4 hi_ = __builtin_amdgcn_ds_read_tr16_b64_v4i16((LAS s16x4*)(p_ + 4 * LD)); \
        dst = __builtin_shufflevector(lo_, hi_, 0, 1, 2, 3, 4, 5, 6, 7); } while (0)
    bf16x8 wlw[2][2], wla[2][2], wlg[2][4];
    { RK_IDS();
      const bf16_t* WUPT = (const bf16_t*)(F.ws + WS_LORA) + (size_t)h * 64 * 64; const bf16_t* AUPT = (const bf16_t*)(F.ws + WS_LORA) + 512 * 64 + (size_t)h * 64 * 64;
      const bf16_t* GUPT = (const bf16_t*)(F.ws + WS_LORA) + 2 * 512 * 64 + (size_t)h * 64 * 128;
#pragma unroll
      for (int jn = 0; jn < 2; ++jn) { const int n = (nt0 + jn) * 16 + fr;
#pragma unroll
          for (int ks = 0; ks < 2; ++ks) { wlw[jn][ks] = *(const bf16x8*)(WUPT + (size_t)n * 64 + ks * 32 + fq * 8); wla[jn][ks] = *(const bf16x8*)(AUPT + (size_t)n * 64 + ks * 32 + fq * 8); }
#pragma unroll
          for (int ks = 0; ks < 4; ++ks) wlg[jn][ks] = *(const bf16x8*)(GUPT + (size_t)n * 128 + ks * 32 + fq * 8); } }
    const bf16_t* LINb = (const bf16_t*)(F.ws + WS_H) + (size_t)b * SEQ * 256;
    u32x4 pf[14];
#define RK_LOADS(T0N) do { RK_IDS(); const int t_ = (T0N) + tq; const bf16_t* row_ = proj + (size_t)t_ * NPROJ; const bool hp_ = t_ > 0; const u32x4 z_ = {0u, 0u, 0u, 0u}; \
        _Pragma("unroll") for (int w3 = 0; w3 < 3; ++w3) { const int col_ = (w3 == 0 ? C_R : w3 == 1 ? C_K : C_V) + h * 64 + j0; pf[w3] = *(const u32x4*)(row_ + col_); pf[3 + w3] = z_; if (hp_) pf[3 + w3] = *(const u32x4*)(row_ - NPROJ + col_); } \
        const bf16_t* lr_ = LINb + (size_t)((T0N) + mt * 16 + fr) * 256 + fq * 8; \
        _Pragma("unroll") for (int q8 = 0; q8 < 8; ++q8) pf[6 + q8] = *(const u32x4*)(lr_ + q8 * 32); } while (0)
    RK_LOADS(0);
    f32x4 sn[2] = {{0.f, 0.f, 0.f, 0.f}, {0.f, 0.f, 0.f, 0.f}};
    __syncthreads();
#pragma unroll 1
    for (int t0 = 0; t0 < SEQ; t0 += 64) {
        float r8[8], k8[8], v8[8], kk[8];
        {
            RK_IDS();
#pragma unroll
            for (int w3 = 0; w3 < 3; ++w3) {
                const u32x4 pc = pf[w3], pp = pf[3 + w3];
                const f32x4 m0 = *(const LAS f32x4*)(mu + w3 * 64 + j0), m1 = *(const LAS f32x4*)(mu + w3 * 64 + j0 + 4);
#pragma unroll
                for (int q = 0; q < 4; ++q) { const float c0 = bf_lo(pc[q]), c1 = bf_hi(pc[q]), p0 = bf_lo(pp[q]), p1 = bf_hi(pp[q]);
                    const float mu0 = q < 2 ? m0[2 * q] : m1[2 * q - 4], mu1 = q < 2 ? m0[2 * q + 1] : m1[2 * q - 3];
                    const float u0 = c0 + (p0 - c0) * mu0, u1 = c1 + (p1 - c1) * mu1;
                    if (w3 == 0) { r8[2 * q] = u0; r8[2 * q + 1] = u1; } else if (w3 == 1) { k8[2 * q] = u0; k8[2 * q + 1] = u1; } else { v8[2 * q] = u0; v8[2 * q + 1] = u1; } }
            }
            { const f32x4 c0 = *(const LAS f32x4*)(prm + 128 + j0), c1 = *(const LAS f32x4*)(prm + 128 + j0 + 4);
              float ss = 0.f;
#pragma unroll
              for (int q = 0; q < 8; ++q) { kk[q] = k8[q] * (q < 4 ? c0[q] : c1[q - 4]); ss += kk[q] * kk[q]; }
              ss = row8_sum(ss);
              const float inv = fminf(__builtin_amdgcn_rsqf(ss), 1e12f);
#pragma unroll
              for (int q = 0; q < 8; ++q) kk[q] *= inv; }
            { u32x4 w; w.x = cvt_pk_bf16(v8[0], v8[1]); w.y = cvt_pk_bf16(v8[2], v8[3]); w.z = cvt_pk_bf16(v8[4], v8[5]); w.w = cvt_pk_bf16(v8[6], v8[7]); *(LAS u32x4*)(Vm + tq * LD + j0) = w; }
#pragma unroll
            for (int q = 0; q < 8; ++q) asm volatile("" : "+v"(r8[q]), "+v"(k8[q]), "+v"(v8[q]), "+v"(kk[q]));
        }
        f32x4 cgk[2];
        for (int rp_ = 0; rp_ < (RKP == 7 ? 2 : 1); ++rp_) {
        { RK_IDS();
          bf16x8 tri4;
#pragma unroll
          for (int e = 0; e < 8; ++e) tri4[e] = (e < 4 && fq * 4 + e <= fr) ? (short)0x3F80 : (short)0;
#pragma unroll
        for (int jn = 0; jn < 2; ++jn) { const int nt = nt0 + jn; const int n = nt * 16 + fr;
            f32x4 cw = {0.f, 0.f, 0.f, 0.f}, ca = cw, cg = cw;
#pragma unroll
            for (int ks = 0; ks < 2; ++ks) {
                cw = mma(__builtin_bit_cast(bf16x8, pf[6 + ks]), wlw[jn][ks], cw);
                ca = mma(__builtin_bit_cast(bf16x8, pf[8 + ks]), wla[jn][ks], ca); }
#pragma unroll
            for (int ks = 0; ks < 4; ++ks) cg = mma(__builtin_bit_cast(bf16x8, pf[10 + ks]), wlg[jn][ks], cg);
            const float w0v = prm[n], a0v = prm[64 + n];
            float lwv[4];
#pragma unroll
            for (int r = 0; r < 4; ++r) { const int t = mt * 16 + fq * 4 + r;
                lwv[r] = -0.60653066f * fsigmoid(w0v + cw[r]);
                AA[t * LD + n] = f2bf(fsigmoid(a0v + ca[r])); }
            { u32x4 ph = {cvt_pk_bf16(lwv[0], lwv[1]), cvt_pk_bf16(lwv[2], lwv[3]), 0u, 0u};
              u32x4 pl = {cvt_pk_bf16(lwv[0] - bf_lo(ph.x), lwv[1] - bf_hi(ph.x)), cvt_pk_bf16(lwv[2] - bf_lo(ph.y), lwv[3] - bf_hi(ph.y)), 0u, 0u};
              f32x4 cl = {0.f, 0.f, 0.f, 0.f};
              cl = mma(tri4, __builtin_bit_cast(bf16x8, ph), cl); cl = mma(tri4, __builtin_bit_cast(bf16x8, pl), cl);
#pragma unroll
              for (int r = 0; r < 4; ++r) LAMf[(mt * 16 + fq * 4 + r) * LD + n] = __expf(cl[r]);
              if (fq == 3) et[mt * 64 + n] = __expf(cl[3]); }
            cgk[jn] = cg;
        } }
        if (RKP == 7 && rp_ == 0) __syncthreads(); }
        if (t0 + 64 < SEQ) { RK_LOADS(t0 + 64); if (RKP == 4) { __syncthreads(); RK_LOADS(t0 + 64); } }
        __syncthreads();
        for (int rp_ = 0; rp_ < (RKP == 9 ? 2 : 1); ++rp_) {
        {
            RK_IDS();
            float a8[8], lt[8], lp[8];
            { const u32x4 av = *(const LAS u32x4*)(AA + tq * LD + j0);
#pragma unroll
              for (int q = 0; q < 4; ++q) { a8[2 * q] = bf_lo(av[q]); a8[2 * q + 1] = bf_hi(av[q]); } }
            { const int tp = tq > 0 ? tq - 1 : 0;
              const f32x4 l0 = *(const LAS f32x4*)(LAMf + tq * LD + j0), l1 = *(const LAS f32x4*)(LAMf + tq * LD + j0 + 4), q0 = *(const LAS f32x4*)(LAMf + tp * LD + j0), q1 = *(const LAS f32x4*)(LAMf + tp * LD + j0 + 4);
              f32x4 p0 = {1.f, 1.f, 1.f, 1.f}, p1 = p0;
              const int mtile = F.wave >> 1;
              for (int mm = 0; mm < mtile; ++mm) { p0 *= *(const LAS f32x4*)(et + mm * 64 + j0); p1 *= *(const LAS f32x4*)(et + mm * 64 + j0 + 4); }
              const bool first = (tq & 15) == 0;
#pragma unroll
              for (int q = 0; q < 8; ++q) { const float pm = q < 4 ? p0[q] : p1[q - 4]; lt[q] = (q < 4 ? l0[q] : l1[q - 4]) * pm; const float pv = (q < 4 ? q0[q] : q1[q - 4]) * pm; lp[q] = first ? pm : pv; }
              if (tq == 63) {
#pragma unroll
                  for (int q = 0; q < 8; ++q) gL[j0 + q] = lt[q]; } }
            { const int mtc = F.wave >> 1, ntc = (F.wave & 1) * 2;
#pragma unroll
              for (int jn = 0; jn < 2; ++jn)
#pragma unroll
                  for (int r = 0; r < 4; ++r) GG[(mtc * 16 + fq * 4 + r) * LD + (ntc + jn) * 16 + fr] = f2bf(cgk[jn][r]); }
            float kp[8], bs = 0.f;
            { const f32x4 ka0 = *(const LAS f32x4*)(prm + 192 + j0), ka1 = *(const LAS f32x4*)(prm + 192 + j0 + 4), rk0 = *(const LAS f32x4*)(prm + 256 + j0), rk1 = *(const LAS f32x4*)(prm + 256 + j0 + 4);
#pragma unroll
              for (int q = 0; q < 8; ++q) { kp[q] = k8[q] * ((a8[q] - 1.0f) * (q < 4 ? ka0[q] : ka1[q - 4]) + 1.0f); bs += r8[q] * kp[q] * (q < 4 ? rk0[q] : rk1[q - 4]); } }
            bs = row8_sum(bs);
            if (seg == 0) bonus[tq] = bs;
            float at[8], rt[8], bt[8], kt[8];
#pragma unroll
            for (int q = 0; q < 8; ++q) { const float eP = lp[q], eT = lt[q], eN = __builtin_amdgcn_rcpf(lt[q]);
                at[q] = -kk[q] * eP; rt[q] = r8[q] * eT; bt[q] = kk[q] * a8[q] * eN; kt[q] = kp[q] * eN; }
            u32x4 w;
            w.x = cvt_pk_bf16(at[0], at[1]); w.y = cvt_pk_bf16(at[2], at[3]); w.z = cvt_pk_bf16(at[4], at[5]); w.w = cvt_pk_bf16(at[6], at[7]); *(LAS u32x4*)(At + tq * LD + j0) = w;
            w.x = cvt_pk_bf16(rt[0], rt[1]); w.y = cvt_pk_bf16(rt[2], rt[3]); w.z = cvt_pk_bf16(rt[4], rt[5]); w.w = cvt_pk_bf16(rt[6], rt[7]); *(LAS u32x4*)(Rt + tq * LD + j0) = w;
            w.x = cvt_pk_bf16(bt[0], bt[1]); w.y = cvt_pk_bf16(bt[2], bt[3]); w.z = cvt_pk_bf16(bt[4], bt[5]); w.w = cvt_pk_bf16(bt[6], bt[7]); *(LAS u32x4*)(Bt + tq * LD + j0) = w;
            w.x = cvt_pk_bf16(kt[0], kt[1]); w.y = cvt_pk_bf16(kt[2], kt[3]); w.z = cvt_pk_bf16(kt[4], kt[5]); w.w = cvt_pk_bf16(kt[6], kt[7]); *(LAS u32x4*)(Kt + tq * LD + j0) = w;
        }
        if (RKP == 9 && rp_ == 0) __syncthreads(); }
        __syncthreads();
        for (int rp_ = 0; rp_ < (RKP == 1 ? 2 : 1); ++rp_) {
        { RK_IDS();
          { const u32x4 z = {0u, 0u, 0u, 0u}; for (int i = tidv_; i < SLOT / 16; i += NTHR) ((LAS u32x4*)Tm)[i] = z; }
          bf16x8 fb[2], fk[2], fa[2][2], frr[2][2];
#pragma unroll
          for (int ks = 0; ks < 2; ++ks) { const int kc = ks * 32 + fq * 8; fb[ks] = FRN(Bt, mt * 16 + fr, kc); fk[ks] = FRN(Kt, mt * 16 + fr, kc);
#pragma unroll
              for (int jn = 0; jn < 2; ++jn) { fa[jn][ks] = FRN(At, (nt0 + jn) * 16 + fr, kc); frr[jn][ks] = FRN(Rt, (nt0 + jn) * 16 + fr, kc); } }
          f32x4 c1[2][4];
#pragma unroll
          for (int jn = 0; jn < 2; ++jn) {
#pragma unroll
              for (int i = 0; i < 4; ++i) c1[jn][i] = (f32x4){0.f, 0.f, 0.f, 0.f};
#pragma unroll
              for (int ks = 0; ks < 2; ++ks) { c1[jn][0] = mma(fb[ks], fa[jn][ks], c1[jn][0]); c1[jn][1] = mma(fk[ks], fa[jn][ks], c1[jn][1]); c1[jn][2] = mma(fb[ks], frr[jn][ks], c1[jn][2]); c1[jn][3] = mma(fk[ks], frr[jn][ks], c1[jn][3]); } }
#pragma unroll
        for (int jn = 0; jn < 2; ++jn) { const int nt = nt0 + jn;
            f32x4 cbb = c1[jn][0], ckb = c1[jn][1], cbr = c1[jn][2], ckr = c1[jn][3];
            const int t = nt * 16 + fr;
#pragma unroll
            for (int r = 0; r < 4; ++r) { const int sidx = mt * 16 + fq * 4 + r;
                if (!(sidx < t)) { cbb[r] = 0.f; ckb[r] = 0.f; } if (!(sidx <= t)) { cbr[r] = 0.f; ckr[r] = 0.f; } }
            *(LAS f32x4*)(AabF + t * LD + mt * 16 + fq * 4) = cbb;
            storeT(Aab, mt, nt, fr, fq, cbb); storeT(Aak, mt, nt, fr, fq, ckb); storeT(Arb, mt, nt, fr, fq, cbr); storeT(Ark, mt, nt, fr, fq, ckr);
        } }
        if (RKP == 1 && rp_ == 0) __syncthreads(); }
        __syncthreads();
#define RK_P5A(MT_, NT_, CY_, CS_) do { _Pragma("unroll") for (int ks = 0; ks < 2; ++ks) { const int kc = ks * 32 + fq * 8; bf16x8 fkt, fvn, fvm; \
            FRT(fkt, Kt, ks * 32, 16 * (MT_)); FRT(fvn, Vm, ks * 32, 16 * (NT_)); FRT(fvm, Vm, ks * 32, 16 * (MT_)); \
            CS_ = mma(fkt, fvn, CS_); CY_ = mma(FRN(Sst, (MT_) * 16 + fr, kc), FRN(Rt, (NT_) * 16 + fr, kc), CY_); CY_ = mma(fvm, FRN(Ark, (NT_) * 16 + fr, kc), CY_); } } while (0)
        f32x4 cyp[2], csp[2];
        for (int rp_ = 0; rp_ < (RKP == 2 ? 2 : 1); ++rp_) {
        cyp[0] = (f32x4){0.f, 0.f, 0.f, 0.f}; cyp[1] = cyp[0]; csp[0] = cyp[0]; csp[1] = cyp[0];
        if (F.wave == 0) {
            RK_IDS();
            { const int d = lanev_ >> 4, c = lanev_ & 15;
              const LAS float* ab = AabF + (16 * d) * LD + 16 * d;
              float qa[16][16], x[16];
#define RK_LROWS(R0, R1) _Pragma("unroll") for (int r = (R0); r <= (R1); ++r) _Pragma("unroll") for (int pq = 0; pq < r; ++pq) qa[r][pq] = ab[r * LD + pq]
#define RK_SROWS(R0, R1) _Pragma("unroll") for (int r = (R0); r <= (R1); ++r) { float a = (r == c) ? 1.0f : 0.f, a1 = 0.f; \
                  _Pragma("unroll") for (int pq = 0; pq + 1 < r; ++pq) { if (pq & 1) a1 += qa[r][pq] * x[pq]; else a += qa[r][pq] * x[pq]; } \
                  a += a1; if (r > 0) a += qa[r][r - 1] * x[r - 1]; x[r] = a; }
              RK_LROWS(1, 6); RK_LROWS(7, 9); __builtin_amdgcn_sched_barrier(0);
              RK_SROWS(0, 6);
              RK_LROWS(10, 12); __builtin_amdgcn_sched_barrier(0);
              RK_SROWS(7, 9);
              RK_LROWS(13, 15); __builtin_amdgcn_sched_barrier(0);
              RK_SROWS(10, 12);
              RK_SROWS(13, 15);
#undef RK_LROWS
#undef RK_SROWS
#pragma unroll
              for (int r = 0; r < 16; ++r) Tm[(16 * d + r) * LD + 16 * d + c] = f2bf(x[r]); }
            const bf16x8 z8 = {0, 0, 0, 0, 0, 0, 0, 0};
            { bf16x8 a0 = FRN(Aab, 16 + fr, (fq & 1) * 8), a1 = FRN(Aab, 48 + fr, 32 + (fq & 1) * 8), bb0, bb1;
              bf16x8 c0 = FRN(Tm, 16 + fr, 16 + (fq & 1) * 8), c1 = FRN(Tm, 48 + fr, 48 + (fq & 1) * 8);
              FRT(bb0, Tm, 0, 0); FRT(bb1, Tm, 32, 32);
              if (fq >= 2) { a0 = z8; a1 = z8; c0 = z8; c1 = z8; }
              f32x4 e0 = {0.f, 0.f, 0.f, 0.f}, e1 = e0; e0 = mma(a0, bb0, e0); e1 = mma(a1, bb1, e1);
              storeT(EB, 0, 0, fr, fq, e0); storeT(EB, 0, 1, fr, fq, e1);
              bf16x8 g0 = FRN(EB, fr, (fq & 1) * 8), g1 = FRN(EB, 16 + fr, (fq & 1) * 8);
              if (fq >= 2) { g0 = z8; g1 = z8; }
              f32x4 h0 = {0.f, 0.f, 0.f, 0.f}, h1 = h0; h0 = mma(g0, c0, h0); h1 = mma(g1, c1, h1);
              storeT(Tm, 0, 1, fr, fq, h0); storeT(Tm, 2, 3, fr, fq, h1); }
            { bf16x8 bb[2], aA[2], tT[2], eE[2]; f32x4 e[4];
              FRT(bb[0], Tm, 0, 0); FRT(bb[1], Tm, 0, 16);
#pragma unroll
              for (int m2 = 0; m2 < 2; ++m2) { aA[m2] = FRN(Aab, 32 + m2 * 16 + fr, fq * 8); tT[m2] = FRN(Tm, 32 + m2 * 16 + fr, 32 + fq * 8); }
#pragma unroll
              for (int tl = 0; tl < 4; ++tl) { e[tl] = (f32x4){0.f, 0.f, 0.f, 0.f}; e[tl] = mma(aA[tl >> 1], bb[tl & 1], e[tl]); }
#pragma unroll
              for (int tl = 0; tl < 4; ++tl) storeT(EB, 2 + (tl >> 1), tl & 1, fr, fq, e[tl]);
#pragma unroll
              for (int n2 = 0; n2 < 2; ++n2) eE[n2] = FRN(EB, n2 * 16 + fr, 32 + fq * 8);
#pragma unroll
              for (int tl = 0; tl < 4; ++tl) { e[tl] = (f32x4){0.f, 0.f, 0.f, 0.f}; e[tl] = mma(eE[tl & 1], tT[tl >> 1], e[tl]); }
#pragma unroll
              for (int tl = 0; tl < 4; ++tl) storeT(Tm, tl & 1, 2 + (tl >> 1), fr, fq, e[tl]); }
        } else if (F.wave >= 4) {
            RK_IDS(); const int mtw = F.wave - 4;
            bf16x8 fak[2], fat[2];
#pragma unroll
            for (int ks = 0; ks < 2; ++ks) { fak[ks] = FRN(Aak, mtw * 16 + fr, ks * 32 + fq * 8); fat[ks] = FRN(At, mtw * 16 + fr, ks * 32 + fq * 8); }
#pragma unroll
            for (int np = 0; np < 2; ++np) {
                bf16x8 bv[2][2], bs[2][2]; f32x4 cwv[2];
#pragma unroll
                for (int j2 = 0; j2 < 2; ++j2)
#pragma unroll
                    for (int ks = 0; ks < 2; ++ks) { FRT(bv[j2][ks], Vm, ks * 32, 16 * (np * 2 + j2)); bs[j2][ks] = FRN(Sst, (np * 2 + j2) * 16 + fr, ks * 32 + fq * 8); }
#pragma unroll
                for (int j2 = 0; j2 < 2; ++j2) { cwv[j2] = (f32x4){0.f, 0.f, 0.f, 0.f};
#pragma unroll
                    for (int ks = 0; ks < 2; ++ks) { cwv[j2] = mma(fak[ks], bv[j2][ks], cwv[j2]); cwv[j2] = mma(fat[ks], bs[j2][ks], cwv[j2]); } }
#pragma unroll
                for (int j2 = 0; j2 < 2; ++j2) storeT(WT, mtw, np * 2 + j2, fr, fq, cwv[j2]); }
        }
        if (F.wave != 0) { RK_IDS();
            RK_P5A(mt, nt0, cyp[0], csp[0]); RK_P5A(mt, nt0 + 1, cyp[1], csp[1]);
            if (F.wave <= 2) { f32x4 hy = {0.f, 0.f, 0.f, 0.f}, hs = hy; const int ntw = F.wave - 1;
                RK_P5A(0, ntw, hy, hs);
                *(LAS f32x4*)(H0 + ((ntw * 2 + 0) * 64 + lanev_) * 4) = hy; *(LAS f32x4*)(H0 + ((ntw * 2 + 1) * 64 + lanev_) * 4) = hs; } }
        if (RKP == 2 && rp_ == 0) __syncthreads(); }
        __syncthreads();
        for (int rp_ = 0; rp_ < (RKP == 3 ? 2 : 1); ++rp_) {
        { RK_IDS();
          bf16x8 ft[2], fw[2][2]; f32x4 cu[2];
#pragma unroll
          for (int ks = 0; ks < 2; ++ks) { const int kc = ks * 32 + fq * 8; ft[ks] = FRN(Tm, mt * 16 + fr, kc); fw[0][ks] = FRN(WT, nt0 * 16 + fr, kc); fw[1][ks] = FRN(WT, (nt0 + 1) * 16 + fr, kc); }
#pragma unroll
          for (int jn = 0; jn < 2; ++jn) { cu[jn] = (f32x4){0.f, 0.f, 0.f, 0.f};
#pragma unroll
              for (int ks = 0; ks < 2; ++ks) cu[jn] = mma(ft[ks], fw[jn][ks], cu[jn]); }
#pragma unroll
          for (int jn = 0; jn < 2; ++jn) storeT(U0T, mt, nt0 + jn, fr, fq, cu[jn]); }
        if (RKP == 3 && rp_ == 0) __syncthreads(); }
        __syncthreads();
        for (int rp_ = 0; rp_ < (RKP == 5 ? 2 : 1); ++rp_) {
        { RK_IDS();
          bf16x8 fbt[2], fum[2], fun[2][2], frb[2][2]; f32x4 cy2[2], cs2[2];
#pragma unroll
          for (int ks = 0; ks < 2; ++ks) { const int kc = ks * 32 + fq * 8; FRT(fbt[ks], Bt, ks * 32, 16 * mt); fum[ks] = FRN(U0T, mt * 16 + fr, kc);
#pragma unroll
              for (int jn = 0; jn < 2; ++jn) { fun[jn][ks] = FRN(U0T, (nt0 + jn) * 16 + fr, kc); frb[jn][ks] = FRN(Arb, (nt0 + jn) * 16 + fr, kc); } }
#pragma unroll
          for (int jn = 0; jn < 2; ++jn) { cy2[jn] = cyp[jn]; cs2[jn] = csp[jn];
              if (F.wave == 0) { cy2[jn] = *(const LAS f32x4*)(H0 + ((jn * 2 + 0) * 64 + lanev_) * 4); cs2[jn] = *(const LAS f32x4*)(H0 + ((jn * 2 + 1) * 64 + lanev_) * 4); } }
#pragma unroll
          for (int jn = 0; jn < 2; ++jn)
#pragma unroll
              for (int ks = 0; ks < 2; ++ks) { cs2[jn] = mma(fbt[ks], fun[jn][ks], cs2[jn]);
                  cy2[jn] = mma(fum[ks], frb[jn][ks], cy2[jn]); }
#pragma unroll
        for (int jn = 0; jn < 2; ++jn) { const int nt = nt0 + jn;
            const f32x4 cy = cy2[jn], cs = cs2[jn];
            if (rp_ == 0) {
#pragma unroll
                for (int r = 0; r < 4; ++r) sn[jn][r] = (sn[jn][r] + cs[r]) * gL[mt * 16 + fq * 4 + r]; }
            *(LAS f32x4*)(Yf + (nt * 16 + fr) * LD + mt * 16 + fq * 4) = cy; } }
        if (RKP == 5 && rp_ == 0) __syncthreads(); }
        __syncthreads();
        for (int rp_ = 0; rp_ < (RKP == 6 ? 2 : 1); ++rp_) {
        {
            RK_IDS();
            storeT(Sst, mt, nt0, fr, fq, sn[0]); storeT(Sst, mt, nt0 + 1, fr, fq, sn[1]);
            float y[8]; { const f32x4 y0 = *(const LAS f32x4*)(Yf + tq * LD + j0), y1 = *(const LAS f32x4*)(Yf + tq * LD + j0 + 4);
                y[0] = y0.x; y[1] = y0.y; y[2] = y0.z; y[3] = y0.w; y[4] = y1.x; y[5] = y1.y; y[6] = y1.z; y[7] = y1.w; }
            float sm = 0.f;
#pragma unroll
            for (int q = 0; q < 8; ++q) sm += y[q];
            sm = row8_sum(sm); const float mean = sm * (1.0f / 64.0f);
            float vs = 0.f;
#pragma unroll
            for (int q = 0; q < 8; ++q) { y[q] -= mean; vs += y[q] * y[q]; }
            vs = row8_sum(vs); const float rstd = __builtin_amdgcn_rsqf(vs * (1.0f / 64.0f) + 64e-5f);
            const u32x4 gv = *(const LAS u32x4*)(GG + tq * LD + j0); const float bn = bonus[tq];
            float g8[8];
#pragma unroll
            for (int q = 0; q < 4; ++q) { g8[2 * q] = bf_lo(gv[q]); g8[2 * q + 1] = bf_hi(gv[q]); }
            float o[8];
#pragma unroll
            for (int q = 0; q < 8; ++q) o[q] = (y[q] * rstd * prm[320 + j0 + q] + prm[384 + j0 + q] + bn * v8[q]) * g8[q];
            u32x4 w; w.x = cvt_pk_bf16(o[0], o[1]); w.y = cvt_pk_bf16(o[2], o[3]); w.z = cvt_pk_bf16(o[4], o[5]); w.w = cvt_pk_bf16(o[6], o[7]);
            *(u32x4*)(mix + (size_t)(t0 + tq) * D + j0) = w;
        }
        if (RKP == 6 && rp_ == 0) __syncthreads(); }
    }
#undef RK_IDS
#undef RK_LOADS
#undef FRN
#undef FRT
}

__device__ __forceinline__ float softcap15(float z) { return 15.0f * ftanh(z * (1.0f / 15.0f)); }
constexpr int ML_NA = 21;
__device__ __forceinline__ void p4_mlstm_v2(Frame& F) {
    if (F.bid >= 256) return;
    constexpr int LD = 72, LDV = 136, LDN = 132;
    const bool second = F.bid >= 128; const int chain = F.bid & 127;
    const int b = chain >> 2, h = chain & 3;
    const bf16_t* proj = (const bf16_t*)(F.ws + WS_PROJ) + (size_t)b * SEQ * NPROJ;
    const float* gates = (const float*)(F.ws + WS_GATES) + (size_t)b * SEQ * 8;
    bf16_t* mix = (bf16_t*)(F.ws + WS_MIX) + (size_t)b * SEQ * D + 512 + h * 128;
    LAS unsigned char* L = F.lds;
    LAS bf16_t* Qs = (LAS bf16_t*)(L + 0);
    LAS bf16_t* Qb = (LAS bf16_t*)(L + 9216);
    LAS bf16_t* Ks = (LAS bf16_t*)(L + 18432);
    LAS bf16_t* Kw = (LAS bf16_t*)(L + 27648);
    LAS bf16_t* Vm = (LAS bf16_t*)(L + 36864);
    LAS bf16_t* Sc = (LAS bf16_t*)(L + 54272);
    LAS bf16_t* CT = (LAS bf16_t*)(L + 63488);
    LAS float* Num = (LAS float*)(L + 81920);
    LAS float* nvec = (LAS float*)(L + 115712) + 128;
    LAS float* cw = nvec + 128;
    LAS float* cb = cw + 512;
    LAS float* hnw = cb + 128;
    LAS float* dpv = hnw + 128;
    LAS float* gbuf = dpv + 64;
    for (int i = F.tid; i < 512; i += NTHR) { const int j = i >> 7, c = i & 127; const int col = c < 64 ? (h * 64 + c) : (256 + h * 64 + (c - 64)); cw[i] = F.in[I_CONVW][j * 512 + col]; }
    for (int i = F.tid; i < 128; i += NTHR) { const int col = i < 64 ? (h * 64 + i) : (256 + h * 64 + (i - 64)); cb[i] = F.in[I_CONVB][col]; hnw[i] = F.in[I_HNW][h * 128 + i]; }
    for (int i = F.tid; i < 128 * LD / 2; i += NTHR) ((LAS unsigned*)CT)[i] = 0u;
    if (F.tid < 128) nvec[F.tid] = 0.f;
    LAS float* linmu = (LAS float*)(L + 122880);
    for (int i = F.tid; i < 256; i += NTHR) linmu[i] = F.in[I_MU][C_WD + i];
    const bf16_t* projAll = (const bf16_t*)(F.ws + WS_PROJ); bf16_t* LINo = (bf16_t*)(F.ws + WS_H);
    u32x4 lpc = {0u, 0u, 0u, 0u}, lpp = lpc;
#define LIN_LOAD(K) do { ML_IDS(); const int v_ = F.bid * NTHR + tidv_ + (K) * (256 * NTHR); const int t_ = v_ >> 5; const bf16_t* row_ = projAll + (size_t)t_ * NPROJ + C_WD + (tidv_ & 31) * 8; \
        lpc = *(const u32x4*)row_; lpp = (u32x4){0u, 0u, 0u, 0u}; if ((t_ & (SEQ - 1)) != 0) lpp = *(const u32x4*)(row_ - NPROJ); } while (0)
#define LIN_FINISH(K) do { ML_IDS(); const int cv_ = tidv_ & 31; const int v_ = F.bid * NTHR + tidv_ + (K) * (256 * NTHR); const int t_ = v_ >> 5; \
        const float al_ = cv_ < 8 ? 2.0f : 1.0f, ga_ = cv_ < 8 ? -1.0f : 0.f; const bool plain_ = cv_ >= 8 && cv_ < 16;         \
        const f32x4 m0_ = *(const LAS f32x4*)(linmu + cv_ * 8), m1_ = *(const LAS f32x4*)(linmu + cv_ * 8 + 4); float u_[8]; \
        _Pragma("unroll") for (int q = 0; q < 4; ++q) { const float c0 = bf_lo(lpc[q]), c1 = bf_hi(lpc[q]), p0 = bf_lo(lpp[q]), p1 = bf_hi(lpp[q]); \
            const float mu0 = q < 2 ? m0_[2 * q] : m1_[2 * q - 4], mu1 = q < 2 ? m0_[2 * q + 1] : m1_[2 * q - 3]; u_[2 * q] = c0 + (p0 - c0) * mu0; u_[2 * q + 1] = c1 + (p1 - c1) * mu1; } \
        _Pragma("unroll") for (int q = 0; q < 8; ++q) { const float sg = al_ * fsigmoid(al_ * u_[q]) + ga_; u_[q] = plain_ ? u_[q] : sg; } \
        u32x4 w_; w_.x = cvt_pk_bf16(u_[0], u_[1]); w_.y = cvt_pk_bf16(u_[2], u_[3]); w_.z = cvt_pk_bf16(u_[4], u_[5]); w_.w = cvt_pk_bf16(u_[6], u_[7]); \
        *(u32x4*)(LINo + (size_t)t_ * 256 + cv_ * 8) = w_; } while (0)
    const float ib = F.in[I_IB][h], fb = F.in[I_FB][h];
    const int mtl = F.wave >> 1, nh = F.wave & 1;
    f32x4 Cacc[4]; f32x4 nacc = {0.f, 0.f, 0.f, 0.f};
#pragma unroll
    for (int j = 0; j < 4; ++j) Cacc[j] = (f32x4){0.f, 0.f, 0.f, 0.f};
#define ML_IDS() int tidv_ = F.tid; asm volatile("" : "+v"(tidv_)); const int lanev_ = tidv_ & 63; const int fr = lanev_ & 15, fq = lanev_ >> 4; const int tq = tidv_ >> 3, seg = tidv_ & 7; (void)fr; (void)fq; (void)tq; (void)seg
#define MFRN(M, ld, row, k) (*(const LAS bf16x8*)((M) + (row) * (ld) + (k)))
#define MFRT(dst, M, ld, k0, c0) do { const LAS bf16_t* p_ = (M) + ((k0) + 8 * fq + (fr >> 2)) * (ld) + (c0) + 4 * (fr & 3); \
        const s16x4 lo_ = __builtin_amdgcn_ds_read_tr16_b64_v4i16((LAS s16x4*)p_); const s16x4 hi_ = __builtin_amdgcn_ds_read_tr16_b64_v4i16((LAS s16x4*)(p_ + 4 * (ld))); \
        dst = __builtin_shufflevector(lo_, hi_, 0, 1, 2, 3, 4, 5, 6, 7); } while (0)
    u32x4 pf[12]; float pig = 0.f, pfg = 0.f;
#pragma unroll
    for (int i = 0; i < 12; ++i) pf[i] = (u32x4){0u, 0u, 0u, 0u};
#define ML_LOADS(T0N, FULL) do { ML_IDS(); const int t_ = (T0N) + tq; const u32x4 z_ = {0u, 0u, 0u, 0u}; const bool isq_ = seg < 4; \
        const int colc_ = isq_ ? (C_MQ + h * 64 + seg * 16) : (C_MK + h * 64 + (seg - 4) * 16); \
        _Pragma("unroll") for (int j_ = 0; j_ < 4; ++j_) { const int tt_ = t_ - 3 + j_; pf[2 * j_] = z_; pf[2 * j_ + 1] = z_; \
            if (tt_ >= 0) { if (FULL) { const bf16_t* rp_ = proj + (size_t)tt_ * NPROJ + colc_; pf[2 * j_] = *(const u32x4*)rp_; pf[2 * j_ + 1] = *(const u32x4*)(rp_ + 8); } \
                            else pf[2 * j_] = *(const u32x4*)(proj + (size_t)tt_ * NPROJ + C_MK + h * 64 + seg * 8); } }     \
        { const bf16_t* vp_ = proj + (size_t)t_ * NPROJ + C_MV + h * 128 + seg * 8; pf[8] = *(const u32x4*)vp_; pf[9] = *(const u32x4*)(vp_ + 64); }     \
        if (FULL) { const bf16_t* op_ = proj + (size_t)t_ * NPROJ + C_MO + h * 128 + seg * 8; pf[10] = *(const u32x4*)op_; pf[11] = *(const u32x4*)(op_ + 64); } \
        if (F.wave == 0) { const float* gp_ = gates + (size_t)((T0N) + lanev_) * 8; pig = gp_[h]; pfg = gp_[4 + h]; } } while (0)
#define ML_GATES(P) do { ML_IDS(); const float liv = softcap15(pig + ib); \
        const float xf = softcap15(pfg + fb); const float lf = fminf(xf, 0.f) - __logf(1.0f + __expf(-fabsf(xf))); float bs = lf; \
        _Pragma("unroll") for (int o = 1; o < 64; o <<= 1) { const float u = __shfl_up(bs, o); if (lanev_ >= o) bs += u; } \
        gbuf[(P) * 128 + lanev_] = bs; gbuf[(P) * 128 + 64 + lanev_] = liv; } while (0)
    const int c_end = second ? 32 : ML_NA;
    { const bool full0 = !second; ML_LOADS(0, full0); }
    if (F.wave == 0) ML_GATES(0);
    __syncthreads();
    int nb = 0;
    int c0 = 0;
    if (second) {
#pragma unroll 1
        for (int c = 0; c < ML_NA; ++c) {
            const int t0 = c * 64;
            {
                ML_IDS();
                const LAS float* bcum = gbuf + (c & 1) * 128; const LAS float* lis = bcum + 64;
                const float bL = bcum[63], bt = bcum[tq], lit = lis[tq];
                const float kwf = __expf(bL - bt + lit);
                const int ck = 64 + seg * 8;
                float o8[8];
#pragma unroll
                for (int q = 0; q < 8; ++q) o8[q] = cb[ck + q];
#pragma unroll
                for (int j = 0; j < 4; ++j) { const u32x4 pv = pf[2 * j];
#pragma unroll
                    for (int q = 0; q < 4; ++q) { o8[2 * q] += cw[j * 128 + ck + 2 * q] * bf_lo(pv[q]); o8[2 * q + 1] += cw[j * 128 + ck + 2 * q + 1] * bf_hi(pv[q]); } }
#pragma unroll
                for (int q = 0; q < 8; ++q) o8[q] = fsilu(o8[q]) * kwf;
                u32x4 w2; w2.x = cvt_pk_bf16(o8[0], o8[1]); w2.y = cvt_pk_bf16(o8[2], o8[3]); w2.z = cvt_pk_bf16(o8[4], o8[5]); w2.w = cvt_pk_bf16(o8[6], o8[7]);
                *(LAS u32x4*)(Kw + tq * LD + seg * 8) = w2;
                *(LAS u32x4*)(Vm + tq * LDV + seg * 8) = pf[8]; *(LAS u32x4*)(Vm + tq * LDV + 64 + seg * 8) = pf[9];
            }
            if (c < 16) LIN_LOAD(c);
            if (c + 1 < c_end) { const bool fulln = (c + 1) >= ML_NA; ML_LOADS(t0 + 64, fulln); }
            __syncthreads();
            {
                ML_IDS();
                const LAS float* bcum = gbuf + (c & 1) * 128;
                const float eL = __expf(bcum[63]);
                bf16x8 ak[2], av[4][2];
#pragma unroll
                for (int ks = 0; ks < 2; ++ks) { MFRT(ak[ks], Kw, LD, ks * 32, 16 * mtl);
#pragma unroll
                    for (int jn = 0; jn < 4; ++jn) MFRT(av[jn][ks], Vm, LDV, ks * 32, 16 * (nh * 4 + jn)); }
#pragma unroll
                for (int jn = 0; jn < 4; ++jn) { Cacc[jn] = Cacc[jn] * eL;
#pragma unroll
                    for (int ks = 0; ks < 2; ++ks) Cacc[jn] = rk::mma(ak[ks], av[jn][ks], Cacc[jn]); }
                if (nh == 0) { bf16x8 ones;
#pragma unroll
                    for (int e = 0; e < 8; ++e) ones[e] = (fr == 0) ? (short)0x3F80 : (short)0;
                    nacc = nacc * eL;
#pragma unroll
                    for (int ks = 0; ks < 2; ++ks) nacc = rk::mma(ak[ks], ones, nacc);
                    if (fr == 0) {
#pragma unroll
                        for (int r = 0; r < 4; ++r) nvec[(nb ^ 1) * 64 + mtl * 16 + fq * 4 + r] = nacc[r]; } }
            }
            if (c < 16) LIN_FINISH(c);
            if (F.wave == 0 && c + 1 < c_end) ML_GATES((c + 1) & 1);
            __syncthreads();
            if (c == ML_NA - 1) { ML_IDS();
#pragma unroll
                for (int jn = 0; jn < 4; ++jn) { const int ntl = nh * 4 + jn; u32x2 w; w.x = cvt_pk_bf16(Cacc[jn][0], Cacc[jn][1]); w.y = cvt_pk_bf16(Cacc[jn][2], Cacc[jn][3]);
                    *(LAS u32x2*)(CT + (ntl * 16 + fr) * LD + mtl * 16 + fq * 4) = w; } }
            nb ^= 1;
        }
        c0 = ML_NA;
    }
#pragma unroll 1
    for (int c = c0; c < c_end; ++c) {
        const int t0 = c * 64; constexpr bool full = true;
        {
            ML_IDS();
            const LAS float* bcum = gbuf + (c & 1) * 128; const LAS float* lis = bcum + 64;
            const float bL = bcum[63], bt = bcum[tq], lit = lis[tq];
            const float eb = __expf(bt), kwf = __expf(bL - bt + lit);
            const bool isq = seg < 4; const int c0 = seg * 16;
            if (full || !isq) {
                float o[16];
#pragma unroll
                for (int q = 0; q < 16; ++q) o[q] = cb[c0 + q];
#pragma unroll
                for (int j = 0; j < 4; ++j) {
#pragma unroll
                    for (int hh = 0; hh < 2; ++hh) { const u32x4 p = pf[2 * j + hh];
#pragma unroll
                        for (int q = 0; q < 4; ++q) { o[hh * 8 + 2 * q] += cw[j * 128 + c0 + hh * 8 + 2 * q] * bf_lo(p[q]); o[hh * 8 + 2 * q + 1] += cw[j * 128 + c0 + hh * 8 + 2 * q + 1] * bf_hi(p[q]); } } }
                const float sc1 = isq ? 0.125f : 1.0f, sc2 = isq ? 0.125f * eb : kwf;
#pragma unroll
                for (int q = 0; q < 16; ++q) o[q] = fsilu(o[q]);
                LAS bf16_t* d1 = (isq ? Qs : Ks) + tq * LD + (c0 & 63); LAS bf16_t* d2 = (isq ? Qb : Kw) + tq * LD + (c0 & 63);
#pragma unroll
                for (int hh = 0; hh < 2; ++hh) { u32x4 w1, w2;
                    w1.x = cvt_pk_bf16(o[hh * 8 + 0] * sc1, o[hh * 8 + 1] * sc1); w1.y = cvt_pk_bf16(o[hh * 8 + 2] * sc1, o[hh * 8 + 3] * sc1); w1.z = cvt_pk_bf16(o[hh * 8 + 4] * sc1, o[hh * 8 + 5] * sc1); w1.w = cvt_pk_bf16(o[hh * 8 + 6] * sc1, o[hh * 8 + 7] * sc1);
                    w2.x = cvt_pk_bf16(o[hh * 8 + 0] * sc2, o[hh * 8 + 1] * sc2); w2.y = cvt_pk_bf16(o[hh * 8 + 2] * sc2, o[hh * 8 + 3] * sc2); w2.z = cvt_pk_bf16(o[hh * 8 + 4] * sc2, o[hh * 8 + 5] * sc2); w2.w = cvt_pk_bf16(o[hh * 8 + 6] * sc2, o[hh * 8 + 7] * sc2);
                    *(LAS u32x4*)(d1 + hh * 8) = w1; *(LAS u32x4*)(d2 + hh * 8) = w2; }
            }
            *(LAS u32x4*)(Vm + tq * LDV + seg * 8) = pf[8]; *(LAS u32x4*)(Vm + tq * LDV + 64 + seg * 8) = pf[9];
        }
        const u32x4 og0 = pf[10], og1 = pf[11];
        if (c < 16) LIN_LOAD(c);
        if (c + 1 < c_end) ML_LOADS(t0 + 64, true);
        __syncthreads();
        {
            ML_IDS();
            const LAS float* bcum = gbuf + (c & 1) * 128; const LAS float* lis = bcum + 64;
            const float eL = __expf(bcum[63]);
            bf16x8 ak[2], av[4][2];
            if (full) { const int tt = mtl, hh = nh;
                const int t = tt * 16 + fr; const float btv = bcum[t];
                f32x4 g4[4], dm[4];
                { bf16x8 fks[4][2], fqs[2];
#pragma unroll
                  for (int ks = 0; ks < 2; ++ks) fqs[ks] = MFRN(Qs, LD, tt * 16 + fr, ks * 32 + fq * 8);
#pragma unroll
                  for (int ms = 0; ms < 4; ++ms) if (ms <= tt) {
#pragma unroll
                      for (int ks = 0; ks < 2; ++ks) fks[ms][ks] = MFRN(Ks, LD, ms * 16 + fr, ks * 32 + fq * 8); }
#pragma unroll
                  for (int ms = 0; ms < 4; ++ms) { g4[ms] = (f32x4){0.f, 0.f, 0.f, 0.f}; dm[ms] = g4[ms];
                      if (ms <= tt) {
                          const f32x4 bc = *(const LAS f32x4*)(bcum + ms * 16 + fq * 4), li = *(const LAS f32x4*)(lis + ms * 16 + fq * 4);
#pragma unroll
                          for (int ks = 0; ks < 2; ++ks) g4[ms] = rk::mma(fks[ms][ks], fqs[ks], g4[ms]);
#pragma unroll
                          for (int r = 0; r < 4; ++r) dm[ms][r] = (ms * 16 + fq * 4 + r <= t) ? __expf(btv - bc[r] + li[r]) : 0.f; } } }
                f32x4 a4[4]; bf16x8 bq[2];
#pragma unroll
                for (int ks = 0; ks < 2; ++ks) bq[ks] = MFRN(Qb, LD, tt * 16 + fr, ks * 32 + fq * 8);
#pragma unroll
                for (int jn = 0; jn < 4; ++jn) { a4[jn] = (f32x4){0.f, 0.f, 0.f, 0.f};
#pragma unroll
                    for (int ks = 0; ks < 2; ++ks) a4[jn] = rk::mma(MFRN(CT, LD, (hh * 4 + jn) * 16 + fr, ks * 32 + fq * 8), bq[ks], a4[jn]); }
                if (hh == 0) {
                    f32x4 dd = {0.f, 0.f, 0.f, 0.f};
#pragma unroll
                    for (int ks = 0; ks < 2; ++ks) { const f32x4 n0 = *(const LAS f32x4*)(nvec + nb * 64 + ks * 32 + fq * 8), n1 = *(const LAS f32x4*)(nvec + nb * 64 + ks * 32 + fq * 8 + 4);
                        u32x4 hi = {cvt_pk_bf16(n0[0], n0[1]), cvt_pk_bf16(n0[2], n0[3]), cvt_pk_bf16(n1[0], n1[1]), cvt_pk_bf16(n1[2], n1[3])};
                        u32x4 lo = {cvt_pk_bf16(n0[0] - bf_lo(hi.x), n0[1] - bf_hi(hi.x)), cvt_pk_bf16(n0[2] - bf_lo(hi.y), n0[3] - bf_hi(hi.y)), cvt_pk_bf16(n1[0] - bf_lo(hi.z), n1[1] - bf_hi(hi.z)), cvt_pk_bf16(n1[2] - bf_lo(hi.w), n1[3] - bf_hi(hi.w))};
                        const u32x4 z = {0u, 0u, 0u, 0u}; const u32x4 an = fr == 0 ? hi : fr == 1 ? lo : z;
                        dd = rk::mma(__builtin_bit_cast(bf16x8, an), bq[ks], dd); }
                    if (fq == 0) dpv[tt * 16 + fr] = dd[0] + dd[1]; }
#pragma unroll
                for (int ks = 0; ks < 2; ++ks) { MFRT(ak[ks], Kw, LD, ks * 32, 16 * mtl);
#pragma unroll
                    for (int jn = 0; jn < 4; ++jn) MFRT(av[jn][ks], Vm, LDV, ks * 32, 16 * (hh * 4 + jn)); }
#pragma unroll
                for (int ms = 0; ms < 4; ++ms) { const f32x4 g = g4[ms] * dm[ms];
                    u32x2 w; w.x = cvt_pk_bf16(g[0], g[1]); w.y = cvt_pk_bf16(g[2], g[3]); *(LAS u32x2*)(Sc + t * LD + ms * 16 + fq * 4) = w; }
                bf16x8 bs[2];
#pragma unroll
                for (int ks = 0; ks < 2; ++ks) bs[ks] = MFRN(Sc, LD, tt * 16 + fr, ks * 32 + fq * 8);
#pragma unroll
                for (int jn = 0; jn < 4; ++jn)
#pragma unroll
                    for (int ks = 0; ks < 2; ++ks) a4[jn] = rk::mma(av[jn][ks], bs[ks], a4[jn]);
#pragma unroll
                for (int jn = 0; jn < 4; ++jn) *(LAS f32x4*)(Num + (tt * 16 + fr) * LDN + (hh * 4 + jn) * 16 + fq * 4) = a4[jn];
            } else {
#pragma unroll
                for (int ks = 0; ks < 2; ++ks) { MFRT(ak[ks], Kw, LD, ks * 32, 16 * mtl);
#pragma unroll
                    for (int jn = 0; jn < 4; ++jn) MFRT(av[jn][ks], Vm, LDV, ks * 32, 16 * (nh * 4 + jn)); }
            }
#pragma unroll
            for (int jn = 0; jn < 4; ++jn) {
                Cacc[jn] = Cacc[jn] * eL;
#pragma unroll
                for (int ks = 0; ks < 2; ++ks) Cacc[jn] = rk::mma(ak[ks], av[jn][ks], Cacc[jn]); }
            if (nh == 0) {
                bf16x8 ones;
#pragma unroll
                for (int e = 0; e < 8; ++e) ones[e] = (fr == 0) ? (short)0x3F80 : (short)0;
                nacc = nacc * eL;
#pragma unroll
                for (int ks = 0; ks < 2; ++ks) nacc = rk::mma(ak[ks], ones, nacc);
                if (fr == 0) {
#pragma unroll
                    for (int r = 0; r < 4; ++r) nvec[(nb ^ 1) * 64 + mtl * 16 + fq * 4 + r] = nacc[r]; } }
        }
        if (c < 16) LIN_FINISH(c);
        if (F.wave == 0 && c + 1 < c_end) ML_GATES((c + 1) & 1);
        __syncthreads();
        {
            ML_IDS();
#pragma unroll
            for (int jn = 0; jn < 4; ++jn) { const int ntl = nh * 4 + jn; u32x2 w; w.x = cvt_pk_bf16(Cacc[jn][0], Cacc[jn][1]); w.y = cvt_pk_bf16(Cacc[jn][2], Cacc[jn][3]);
                *(LAS u32x2*)(CT + (ntl * 16 + fr) * LD + mtl * 16 + fq * 4) = w; }
            if (full) {
                const int dv0 = seg * 8;
                float ds;
                { const u32x4 sv = *(const LAS u32x4*)(Sc + tq * LD + seg * 8);
                  ds = (bf_lo(sv.x) + bf_hi(sv.x)) + (bf_lo(sv.y) + bf_hi(sv.y)) + (bf_lo(sv.z) + bf_hi(sv.z)) + (bf_lo(sv.w) + bf_hi(sv.w)); }
                const float den = row8_sum(ds) + dpv[tq];
                const float inv = 1.0f / fmaxf(fabsf(den), 1.0f);
                float hv[16]; float ss = 0.f;
#pragma unroll
                for (int q = 0; q < 4; ++q) { const f32x4 nv = *(const LAS f32x4*)(Num + tq * LDN + dv0 + (q >> 1) * 64 + 4 * (q & 1));
                    hv[4 * q] = nv.x * inv; hv[4 * q + 1] = nv.y * inv; hv[4 * q + 2] = nv.z * inv; hv[4 * q + 3] = nv.w * inv;
                    ss += (hv[4 * q] * hv[4 * q] + hv[4 * q + 1] * hv[4 * q + 1]) + (hv[4 * q + 2] * hv[4 * q + 2] + hv[4 * q + 3] * hv[4 * q + 3]); }
                ss = row8_sum(ss);
                const float rms = __builtin_amdgcn_rsqf(ss * (1.0f / 128.0f) + 1e-6f);
                float ov[16];
#pragma unroll
                for (int q = 0; q < 4; ++q) { ov[2 * q] = bf_lo(og0[q]); ov[2 * q + 1] = bf_hi(og0[q]); ov[8 + 2 * q] = bf_lo(og1[q]); ov[8 + 2 * q + 1] = bf_hi(og1[q]); }
                unsigned pk[8];
#pragma unroll
                for (int q = 0; q < 8; ++q) { const int cq = dv0 + (q >> 2) * 64 + 2 * (q & 3); const float a = hv[2 * q] * rms * hnw[cq] * fsigmoid(ov[2 * q]), cc = hv[2 * q + 1] * rms * hnw[cq + 1] * fsigmoid(ov[2 * q + 1]); pk[q] = cvt_pk_bf16(a, cc); }
                u32x4* dst = (u32x4*)(mix + (size_t)(t0 + tq) * D + dv0);
                dst[0] = (u32x4){pk[0], pk[1], pk[2], pk[3]}; dst[8] = (u32x4){pk[4], pk[5], pk[6], pk[7]};
            }
        }
        nb ^= 1;
    }
#undef ML_GATES
#undef LIN_LOAD
#undef LIN_FINISH
#undef ML_IDS
#undef ML_LOADS
#undef MFRN
#undef MFRT
}

template <bool COUNT> __device__ __forceinline__ void p6_norm2_route(Frame& F) {
    constexpr int LDW = 1032;
    const bf16_t* x1 = (const bf16_t*)(F.ws + WS_X1); const float* nw = F.in[I_FFNNW];
    const float* mod = (const float*)(F.ws + WS_MOD);
    bf16_t* H2 = (bf16_t*)(F.ws + WS_H);
    int* route = (int*)(F.ws + WS_ROUTE); float* routew = (float*)(F.ws + WS_ROUTEW);
    unsigned* cnt = (unsigned*)(F.ws + WS_CTL) + CW_CNT;
    LAS bf16_t* Wr = (LAS bf16_t*)F.lds;
    LAS float* g2 = (LAS float*)(F.lds + 99072);
    LAS float* shv = g2 + 1024;
    LAS float* bl = shv + 1024;
    LAS unsigned* lcnt = (LAS unsigned*)(bl + 48);
    LAS unsigned* lbase = lcnt + 32;
    LAS float* scr = (LAS float*)(lbase + 32) + F.wave * 768;
    LAS int* rec = (LAS int*)((LAS float*)(lbase + 32) + 8 * 768) + F.wave * 192;
    const int b = F.bid >> 3;
    for (int i = F.tid; i < 32 * 1024; i += NTHR) Wr[(4 + (i & 31)) * LDW + (i >> 5)] = f2bf(F.in[I_WRT][i]);
    for (int i = F.tid; i < 4 * 1024; i += NTHR) Wr[(i & 3) * LDW + (i >> 2)] = f2bf(F.in[I_WGRP][i]);
    for (int i = F.tid; i < 12 * 1024; i += NTHR) Wr[(36 + (i >> 10)) * LDW + (i & 1023)] = 0;
    for (int k = F.tid; k < 1024; k += NTHR) { g2[k] = nw[k] * (1.0f + mod[b * 6144 + 4096 + k]); shv[k] = mod[b * 6144 + 3072 + k]; }
    if (F.tid < 48) bl[F.tid] = F.tid < 4 ? F.in[I_BGRP][F.tid] : (F.tid < 36 ? F.in[I_BRT][F.tid - 4] : 0.f);
    if (F.tid < 32) lcnt[F.tid] = 0u;
    __syncthreads();
    const int fr = F.lane & 15, fq = F.lane >> 4;
#pragma unroll 1
    for (int gs = 0; gs < 2; ++gs) {
        const int grp = (F.bid & 7) * 16 + F.wave * 2 + gs;
        const size_t row = (size_t)b * SEQ + grp * 16 + fr;
        const bf16_t* xr = x1 + row * D + fq * 8;
        float ss = 0.f;
#pragma unroll 8
        for (int ks = 0; ks < 32; ++ks) { const u32x4 xv = *(const u32x4*)(xr + ks * 32);
#pragma unroll
            for (int q = 0; q < 4; ++q) { const float lo = bf_lo(xv[q]), hi = bf_hi(xv[q]); ss += lo * lo + hi * hi; } }
        ss += __shfl_xor(ss, 16); ss += __shfl_xor(ss, 32);
        const float rstd = __builtin_amdgcn_rsqf(ss * (1.0f / D) + 1e-6f);
        f32x4 acc[3];
#pragma unroll
        for (int nt = 0; nt < 3; ++nt) acc[nt] = (f32x4){0.f, 0.f, 0.f, 0.f};
        bf16_t* hr = H2 + row * D + fq * 8;
#pragma unroll 4
        for (int ks = 0; ks < 32; ++ks) {
            const int k0 = ks * 32 + fq * 8;
            const f32x4 ga = *(const LAS f32x4*)(g2 + k0), gb = *(const LAS f32x4*)(g2 + k0 + 4), sa = *(const LAS f32x4*)(shv + k0), sb = *(const LAS f32x4*)(shv + k0 + 4);
            const u32x4 xv = *(const u32x4*)(xr + ks * 32);
            u32x4 hw;
            hw.x = cvt_pk_bf16(bf_lo(xv.x) * rstd * ga.x + sa.x, bf_hi(xv.x) * rstd * ga.y + sa.y);
            hw.y = cvt_pk_bf16(bf_lo(xv.y) * rstd * ga.z + sa.z, bf_hi(xv.y) * rstd * ga.w + sa.w);
            hw.z = cvt_pk_bf16(bf_lo(xv.z) * rstd * gb.x + sb.x, bf_hi(xv.z) * rstd * gb.y + sb.y);
            hw.w = cvt_pk_bf16(bf_lo(xv.w) * rstd * gb.z + sb.z, bf_hi(xv.w) * rstd * gb.w + sb.w);
            *(u32x4*)(hr + ks * 32) = hw;
            const bf16x8 af = __builtin_bit_cast(bf16x8, hw);
#pragma unroll
            for (int nt = 0; nt < 3; ++nt) acc[nt] = __builtin_amdgcn_mfma_f32_16x16x32_bf16(af, *(const LAS bf16x8*)(Wr + (nt * 16 + fr) * LDW + k0), acc[nt], 0, 0, 0);
        }
#pragma unroll
        for (int nt = 0; nt < 3; ++nt) { const float bv = bl[nt * 16 + fr];
#pragma unroll
            for (int r = 0; r < 4; ++r) scr[(fq * 4 + r) * 48 + nt * 16 + fr] = acc[nt][r] + bv; }
        if (F.lane < 16) {
            const LAS float* lg = scr + F.lane * 48;
            const float g0 = lg[0], g1 = lg[1], gg2 = lg[2], g3 = lg[3];
            int gi = 0; float gm = g0; if (g1 > gm) { gm = g1; gi = 1; } if (gg2 > gm) { gm = gg2; gi = 2; } if (g3 > gm) { gm = g3; gi = 3; }
            const float gwgt = 1.0f / (__expf(g0 - gm) + __expf(g1 - gm) + __expf(gg2 - gm) + __expf(g3 - gm));
            float ev[8];
#pragma unroll
            for (int q = 0; q < 8; ++q) ev[q] = lg[4 + gi * 8 + q];
            int i0 = 0; float v0 = ev[0];
#pragma unroll
            for (int q = 1; q < 8; ++q) if (ev[q] > v0) { v0 = ev[q]; i0 = q; }
            int i1 = -1; float v1 = -3.0e38f;
#pragma unroll
            for (int q = 0; q < 8; ++q) if (q != i0 && ev[q] > v1) { v1 = ev[q]; i1 = q; }
            const float tw0 = 1.0f / (1.0f + __expf(v1 - v0)), tw1 = 1.0f - tw0;
            const int e0 = gi * 8 + i0, e1 = gi * 8 + i1;
            unsigned r0 = 0u, r1 = 0u;
            if (COUNT) { r0 = __hip_atomic_fetch_add(lcnt + e0, 1u, __ATOMIC_RELAXED, __HIP_MEMORY_SCOPE_WORKGROUP); r1 = __hip_atomic_fetch_add(lcnt + e1, 1u, __ATOMIC_RELAXED, __HIP_MEMORY_SCOPE_WORKGROUP); }
            LAS int* rc = rec + (gs * 16 + F.lane) * 6;
            rc[0] = e0; rc[1] = e1; rc[2] = (int)r0; rc[3] = (int)r1; rc[4] = __float_as_int(gwgt * tw0); rc[5] = __float_as_int(gwgt * tw1);
        }
    }
    __syncthreads();
    if (COUNT && F.tid < 32) lbase[F.tid] = __hip_atomic_fetch_add(cnt + 64 * F.tid, lcnt[F.tid], __ATOMIC_RELAXED, __HIP_MEMORY_SCOPE_AGENT);
    __syncthreads();
    if (COUNT && F.lane < 32) { const LAS int* rc = rec + F.lane * 6; const int grp = (F.bid & 7) * 16 + F.wave * 2 + (F.lane >> 4); const size_t m = (size_t)b * SEQ + grp * 16 + (F.lane & 15);
        *(int4*)(route + m * 4) = make_int4(rc[0], rc[1], rc[2] + (int)lbase[rc[0]], rc[3] + (int)lbase[rc[1]]);
        *(float2*)(routew + m * 2) = make_float2(__int_as_float(rc[4]), __int_as_float(rc[5]));
        unsigned* slotE = (unsigned*)(F.ws + WS_SLOTE);
        slotE[(size_t)rc[0] * 65536 + (unsigned)(rc[2] + (int)lbase[rc[0]])] = (unsigned)m;
        slotE[(size_t)rc[1] * 65536 + (unsigned)(rc[3] + (int)lbase[rc[1]])] = (unsigned)m | 0x40000000u; }
}

__device__ __forceinline__ int moe_table(Frame& F, LAS int* tile_e, LAS int* start) {
    unsigned* cnt = (unsigned*)(F.ws + WS_CTL) + CW_CNT;
    if (F.wave == 0) {
        const int e = F.lane; int c = 0; if (e < NE) c = (int)__hip_atomic_load(cnt + 64 * e, __ATOMIC_RELAXED, __HIP_MEMORY_SCOPE_AGENT);
        const int nt = (c + 255) >> 8; int inc = nt;
#pragma unroll
        for (int o = 1; o < 64; o <<= 1) { const int u = __shfl_up(inc, o); if (F.lane >= o) inc += u; }
        const int st = inc - nt;
        if (e < NE) { start[e] = st; start[40 + e] = c; for (int q = 0; q < nt; ++q) if (st + q < MAXTILES) tile_e[st + q] = e; }
        if (e == NE - 1) start[NE] = inc < MAXTILES ? inc : MAXTILES; }
    __syncthreads();
    return start[NE];
}
__device__ __forceinline__ void p10_final(Frame& F, bool have_table) {
    LAS int* tile_e = (LAS int*)(F.lds + pg8::STAGE_BYTES); LAS int* start = tile_e + MAXTILES;
    if (!have_table) (void)moe_table(F, tile_e, start);
    const float* mod = (const float*)(F.ws + WS_MOD);
    const bf16_t* moes = (const bf16_t*)(F.ws + WS_MOE);
    const int* route = (const int*)(F.ws + WS_ROUTE); const float* routew = (const float*)(F.ws + WS_ROUTEW);
    const float* fw = F.in[I_FINW];
    f32x4 fwv[4];
#pragma unroll
    for (int j = 0; j < 4; ++j) fwv[j] = *(const f32x4*)(fw + 4 * F.lane + 256 * j);
    const int gw = F.bid * NWAVES + F.wave; const int b = gw >> 6; const int r0 = b * SEQ + (gw & 63);
    const int nrows = gw < NB * 64 ? 32 : 0;
    f32x4 gfv[4];
#pragma unroll
    for (int j = 0; j < 4; ++j) gfv[j] = *(const f32x4*)(mod + (b & 31) * 6144 + 5120 + 4 * F.lane + 256 * j);
    int ls0 = 0, ls1 = 0; float lw0 = 0.f, lw1 = 0.f;
    if (F.lane < nrows) { const int m = r0 + 64 * F.lane;
        const int4 rt = *(const int4*)(route + (size_t)m * 4); const float2 rw = *(const float2*)(routew + (size_t)m * 2);
        ls0 = start[rt.x] * 256 + rt.z; ls1 = start[rt.y] * 256 + rt.w; lw0 = rw.x; lw1 = rw.y; }
    const bf16_t* x1 = (const bf16_t*)(F.ws + WS_X1);
    u32x2 xv[4]; u32x2 ma[4], mc[4];
#define P10_LOAD(I) do { const int m_ = r0 + 64 * (I); \
        const size_t s0_ = (size_t)__builtin_amdgcn_readlane(ls0, (I)), s1_ = (size_t)__builtin_amdgcn_readlane(ls1, (I)); \
        const u32x2* xr_ = (const u32x2*)(x1 + (size_t)m_ * D + 4 * F.lane); const u32x2* m0_ = (const u32x2*)(moes + s0_ * D + 4 * F.lane); const u32x2* m1_ = (const u32x2*)(moes + s1_ * D + 4 * F.lane); \
        _Pragma("unroll") for (int j = 0; j < 4; ++j) { xv[j] = __builtin_nontemporal_load(xr_ + 64 * j); ma[j] = __builtin_nontemporal_load(m0_ + 64 * j); mc[j] = __builtin_nontemporal_load(m1_ + 64 * j); } } while (0)
    if (nrows > 0) P10_LOAD(0);
    for (int i = 0; i < nrows; ++i) {
        const int m = r0 + 64 * i;
        const float w0 = __builtin_bit_cast(float, __builtin_amdgcn_readlane(__builtin_bit_cast(int, lw0), i)), w1 = __builtin_bit_cast(float, __builtin_amdgcn_readlane(__builtin_bit_cast(int, lw1), i));
        f32x4 v[4]; float ss = 0.f;
#pragma unroll
        for (int j = 0; j < 4; ++j) { const u32x2 a = ma[j], c = mc[j];
            const f32x4 y = {bf_lo(a.x) * w0 + bf_lo(c.x) * w1, bf_hi(a.x) * w0 + bf_hi(c.x) * w1, bf_lo(a.y) * w0 + bf_lo(c.y) * w1, bf_hi(a.y) * w0 + bf_hi(c.y) * w1};
            const f32x4 xf = {bf_lo(xv[j].x), bf_hi(xv[j].x), bf_lo(xv[j].y), bf_hi(xv[j].y)};
            v[j] = xf + gfv[j] * y; ss += (v[j].x * v[j].x + v[j].y * v[j].y) + (v[j].z * v[j].z + v[j].w * v[j].w); }
        if (i + 1 < nrows) P10_LOAD(i + 1);
        ss = wave_sum(ss);
        const float rstd = __builtin_amdgcn_rsqf(ss * (1.0f / D) + 1e-6f);
        float* xo = F.out + (size_t)m * D + 4 * F.lane;
#pragma unroll
        for (int j = 0; j < 4; ++j) *(f32x4*)(xo + 256 * j) = (v[j] * rstd) * fwv[j];
    }
#undef P10_LOAD
}

constexpr int NPHASE = 11;
__global__ void __launch_bounds__(NTHR, 2) mk_fwd(Args args) {
    extern __shared__ __attribute__((aligned(16))) unsigned char lds_raw[];
    Frame F;
    F.lds = (LAS unsigned char*)lds_raw; F.in = args.in; F.out = args.out; F.ws = args.ws;
    F.tid = threadIdx.x; F.lane = F.tid & 63; F.wave = __builtin_amdgcn_readfirstlane(F.tid >> 6); F.bid = blockIdx.x; F.G = gridDim.x;
    volatile LAS unsigned* MISC = (volatile LAS unsigned*)(F.lds + MISC_OFF);
    if (F.tid < 64) MISC[F.tid] = 0u;
    __syncthreads();
    const int lo = args.ph_lo, hi = args.ph_hi;
    XcdBarrier bar; bar.bar = (unsigned*)(args.ws + WS_CTL) + CW_BAR; bar.x = 0; bar.st = nullptr;
    if (hi - lo > 1) bar = xcd_barrier_post((unsigned*)(args.ws + WS_CTL) + CW_BAR, MISC + 8);
#define IN(k) (lo <= (k) && (k) < hi)
#define SEAM(k) do { if (IN(k) && IN((k) + 1)) xcd_barrier(bar); } while (0)
#define REPS(k) for (int rep = 0; rep < ((MK_DUP == (k)) ? 2 : 1); ++rep)
    if (IN(0)) { REPS(0) { p0_prologue(F); __syncthreads(); } } SEAM(0);
    if (IN(1)) { REPS(1) { p1_norm1(F); __syncthreads(); } } SEAM(1);
#define GEMM_P2() do { DenseOrder<1024> S; S.init(F.ws + WS_H, F.ws + WS_WIN, T, NPROJ, F.G, F.bid, 4); EpiProj E{(bf16_t*)(F.ws + WS_PROJ)}; pg8::gemm_phase<1024, EpiProj, DenseOrder<1024>>(F.lds, S, E); } while (0)
    if (IN(2)) { GEMM_P2(); if (MK_DUP == 2) { __syncthreads(); GEMM_P2(); } } SEAM(2);
    if (IN(3)) { REPS(4) { p4_mlstm_v2(F); __syncthreads(); } } SEAM(3);
    if (IN(4)) { REPS(3) { p3_rwkv_chunked(F); __syncthreads(); } } SEAM(4);
#define GEMM_P5() do { DenseOrder<1024> S; S.init(F.ws + WS_MIX, F.ws + WS_WOUT, T, D, F.G, F.bid); EpiOut E{F.in[I_X], (const float*)(F.ws + WS_MOD), (bf16_t*)(F.ws + WS_X1)}; pg8::gemm_phase<1024, EpiOut, DenseOrder<1024>>(F.lds, S, E); } while (0)
    if (IN(5)) { GEMM_P5(); if (MK_DUP == 5) { __syncthreads(); GEMM_P5(); } } SEAM(5);
    if (IN(6)) { if (MK_DUP == 6) { p6_norm2_route<false>(F); __syncthreads(); } p6_norm2_route<true>(F); } SEAM(6);
#define GEMM_P8() do { LAS int* tile_e = (LAS int*)(F.lds + pg8::STAGE_BYTES); LAS int* start = tile_e + MAXTILES; const int ntiles = moe_table(F, tile_e, start); \
        GateUpOrder S; S.A = (const char*)(F.ws + WS_H); S.W1 = (const char*)(F.ws + WS_W1); S.slotE = (const unsigned*)(F.ws + WS_SLOTE); S.start = start; S.tab = MoeTab{tile_e, ntiles}; S.nwg = ntiles * 2; S.G = F.G; S.c = F.bid; \
        EpiGateUp E{(bf16_t*)(F.ws + WS_HACT)}; pg8::gemm_phase<1024, EpiGateUp, GateUpOrder>(F.lds, S, E); __syncthreads(); } while (0)
#define GEMM_P9() do { LAS int* tile_e = (LAS int*)(F.lds + pg8::STAGE_BYTES); LAS int* start = tile_e + MAXTILES; const int ntiles = IN(8) ? start[NE] : moe_table(F, tile_e, start);     \
        DownOrder S; S.A = (const char*)(F.ws + WS_HACT); S.W2 = (const char*)(F.ws + WS_W2); S.tab = MoeTab{tile_e, ntiles}; S.nwg = ntiles * 4; S.G = F.G; S.c = F.bid; \
        EpiDown E{(bf16_t*)(F.ws + WS_MOE)}; pg8::gemm_phase<256, EpiDown, DownOrder>(F.lds, S, E); __syncthreads(); } while (0)
    if (IN(8)) { GEMM_P8(); if (MK_DUP == 8) GEMM_P8(); } SEAM(8);
    if (IN(9)) { GEMM_P9(); if (MK_DUP == 9) GEMM_P9(); } SEAM(9);
    if (IN(10)) { p10_final(F, IN(9)); }
#undef REPS
#undef IN
#undef SEAM
}

extern "C" void kernel_launch(void* const* d_in, const int* in_sizes, int n_in, void* d_out, int out_size, void* d_ws, size_t ws_size, hipStream_t stream) {
    static int grid = 0;
    if (grid == 0) {
        if (n_in != 32 || in_sizes[0] != T * D || out_size != T * D || ws_size < WS_END) { fprintf(stderr, "kernel_launch: unexpected shapes (n_in %d, in0 %d, out %d, ws %zu); nothing launched\n", n_in, n_in > 0 ? in_sizes[0] : -1, out_size, ws_size); grid = -1; return; }
        int dev = 0, cus = 0, per_cu = 0;
        if (hipGetDevice(&dev) != hipSuccess || hipDeviceGetAttribute(&cus, hipDeviceAttributeMultiprocessorCount, dev) != hipSuccess) { fprintf(stderr, "kernel_launch: device query failed\n"); grid = -1; return; }
        if (hipFuncSetAttribute((const void*)mk_fwd, hipFuncAttributeMaxDynamicSharedMemorySize, LDS_BYTES) != hipSuccess) { fprintf(stderr, "kernel_launch: hipFuncSetAttribute failed\n"); grid = -1; return; }
        if (hipOccupancyMaxActiveBlocksPerMultiprocessor(&per_cu, (const void*)mk_fwd, NTHR, LDS_BYTES) != hipSuccess || per_cu < 1) fprintf(stderr, "kernel_launch: occupancy query reports %d\n", per_cu);
        (void)hipGetLastError();
        grid = cus < 256 ? cus : 256;
        if (grid != 256) fprintf(stderr, "kernel_launch: %d CUs: this kernel is written for 256\n", cus);
    }
    if (grid < 0) return;
    (void)hipMemsetAsync((char*)d_ws + WS_CTL, 0, CTL_ZERO_BYTES, stream);
    Args a{};
    for (int i = 0; i < 32; ++i) a.in[i] = (const float*)d_in[i];
    a.out = (float*)d_out; a.ws = (unsigned char*)d_ws;
#if MK_ONE_LAUNCH
    a.ph_lo = 0; a.ph_hi = NPHASE;
    hipLaunchKernelGGL(mk_fwd, dim3(grid), dim3(NTHR), LDS_BYTES, stream, a);
#else
    for (int p = 0; p < NPHASE; ++p) { a.ph_lo = p; a.ph_hi = p + 1; hipLaunchKernelGGL(mk_fwd, dim3(grid), dim3(NTHR), LDS_BYTES, stream, a); }
#endif
}
```
